# Optimizing an MI355X kernel written in HIP

```python
import math
import jax, jax.numpy as jnp
from jax import lax
import numpy as np

D_MODEL = 1024
BATCH = 8
SEQ = 4096
DEPTH = 2

HEAD_DIM = 64
N_HEADS_A = 4
N_HEADS_B = 4
N_HEADS_C = 4
N_HEADS_D = 4
MIX_WIDTH = HEAD_DIM * (N_HEADS_A + N_HEADS_B + N_HEADS_C + N_HEADS_D)
DIFF_QK_DIM = HEAD_DIM // 2
DILATED_CONFIGS = ((128, 1), (512, 4), (2048, 16))
IDX_HEADS = 16
IDX_DIM = 64
INDEX_TOPK_MAX = 256
N_EXPERTS = 32
TOP_K = 4
D_FF = D_MODEL
SWIGLU_ALPHA = 1.702
SWIGLU_LIMIT = 7.0
N_BUCKETS = 32
MAX_DISTANCE = 128
N_BIAS_HEADS = N_HEADS_B + N_HEADS_C + N_HEADS_D
Q_BLOCK = 128
MOE_BLOCK = 512
LN_EPS = 1e-5
DEEPNORM_ALPHA = (2 * DEPTH) ** 0.25
DEEPNORM_BETA = (8 * DEPTH) ** -0.25

SEG_SIZES = (
    N_HEADS_A * HEAD_DIM, N_HEADS_A * HEAD_DIM, N_HEADS_A * HEAD_DIM,
    N_HEADS_B * HEAD_DIM, N_HEADS_B * HEAD_DIM, N_HEADS_B * HEAD_DIM,
    N_HEADS_C * HEAD_DIM, N_HEADS_C * HEAD_DIM, N_HEADS_C * HEAD_DIM,
    IDX_HEADS * IDX_DIM, IDX_DIM, IDX_HEADS,
    N_HEADS_D * 2 * DIFF_QK_DIM, N_HEADS_D * 2 * DIFF_QK_DIM, N_HEADS_D * HEAD_DIM,
)
IN_COLS = sum(SEG_SIZES)
SPLIT_POINTS = tuple(int(p) for p in np.cumsum(SEG_SIZES)[:-1])

kernel_name = "hybrid_sb_dilated_dsa_diff_moe_deepnorm"


def layer_norm(x, g=None, b=None):
    xf = x.astype(jnp.float32)
    xc = xf - jnp.mean(xf, -1, keepdims=True)
    y = xc * lax.rsqrt(jnp.mean(xc * xc, -1, keepdims=True) + LN_EPS)
    if g is not None:
        y = y * g.astype(jnp.float32) + b.astype(jnp.float32)
    return y.astype(x.dtype)


def rel_bucket(dist):
    n = jnp.maximum(dist, 0)
    max_exact = N_BUCKETS // 2
    nf = jnp.maximum(n, 1).astype(jnp.float32)
    large = max_exact + (jnp.log(nf / max_exact) / math.log(MAX_DISTANCE / max_exact)
                         * (N_BUCKETS - max_exact)).astype(jnp.int32)
    large = jnp.minimum(large, N_BUCKETS - 1)
    return jnp.where(n < max_exact, n, large)


def seq_blocks(a, axis):
    t = a.shape[axis]
    a = a.reshape(a.shape[:axis] + (t // Q_BLOCK, Q_BLOCK) + a.shape[axis + 1:])
    return jnp.moveaxis(a, axis, 0)


def from_blocks(o):
    o = jnp.moveaxis(o, 0, 2)
    return o.reshape(o.shape[:2] + (-1,) + o.shape[4:])


def stick_breaking_attention(q, k, v):
    t, d = q.shape[2], q.shape[3]
    scale = d ** -0.5
    kpos = jnp.arange(t)

    def block(args):
        qi, s0 = args
        qpos = s0 + jnp.arange(Q_BLOCK)
        valid = kpos[None, :] < qpos[:, None]
        z = jnp.einsum('bhqd,bhsd->bhqs', qi, k).astype(jnp.float32) * scale
        log_fail = jnp.where(valid, jax.nn.log_sigmoid(-z), 0.0)
        after = lax.cumsum(log_fail, axis=3, reverse=True) - log_fail
        w = jnp.where(valid, jnp.exp(jax.nn.log_sigmoid(z) + after), 0.0)
        return jnp.einsum('bhqs,bhsd->bhqd', w.astype(v.dtype), v)

    starts = jnp.arange(t // Q_BLOCK) * Q_BLOCK
    return from_blocks(lax.map(block, (seq_blocks(q, 2), starts)))


def dilated_window_attention(q, k, v, bias_tab):
    t, d = q.shape[2], q.shape[3]
    scale = d ** -0.5

    def block(args):
        qi, s0 = args
        qpos = s0 + jnp.arange(Q_BLOCK)
        lses, outs = [], []
        for win, dil in DILATED_CONFIGS:
            dist = jnp.arange(win // dil + 1) * dil
            kidx = qpos[:, None] - dist[None, :]
            valid = kidx >= 0
            kidx = jnp.maximum(kidx, 0)
            kg = jnp.take(k, kidx, axis=2)
            vg = jnp.take(v, kidx, axis=2)
            bias = bias_tab[rel_bucket(dist)].T.astype(jnp.float32)
            z = jnp.einsum('bhqd,bhqmd->bhqm', qi, kg).astype(jnp.float32) * scale + bias[None, :, None, :]
            z = jnp.where(valid[None, None], z, -jnp.inf)
            zmax = jnp.max(z, -1, keepdims=True)
            p = jnp.exp(z - zmax)
            den = jnp.sum(p, -1, keepdims=True)
            outs.append(jnp.einsum('bhqm,bhqmd->bhqd', (p / den).astype(v.dtype), vg))
            lses.append(zmax + jnp.log(den))
        mix = jax.nn.softmax(jnp.concatenate(lses, -1), axis=-1)
        return jnp.einsum('bhqc,cbhqd->bhqd', mix.astype(v.dtype), jnp.stack(outs))

    starts = jnp.arange(t // Q_BLOCK) * Q_BLOCK
    return from_blocks(lax.map(block, (seq_blocks(q, 2), starts)))


def dsa_attention(q, k, v, q_idx, k_idx, w_idx, bias_tab):
    t, d = q.shape[2], q.shape[3]
    topk = min(INDEX_TOPK_MAX, t // 4)
    scale = d ** -0.5
    kpos = jnp.arange(t)

    def block(args):
        qi, qxi, wxi, s0 = args
        qpos = s0 + jnp.arange(Q_BLOCK)
        dots = jnp.einsum('bqhd,bsd->bqhs', qxi, k_idx).astype(jnp.float32) * IDX_DIM ** -0.5
        score = jnp.einsum('bqh,bqhs->bqs', wxi.astype(jnp.float32) * IDX_HEADS ** -0.5, jax.nn.relu(dots))
        score = jnp.where((kpos[None, :] <= qpos[:, None])[None], score, -jnp.inf)
        _, sel = lax.top_k(score, topk)
        kg = jax.vmap(lambda kk, ss: kk[:, ss])(k, sel)
        vg = jax.vmap(lambda vv, ss: vv[:, ss])(v, sel)
        dist = qpos[None, :, None] - sel
        bias = jnp.moveaxis(bias_tab[rel_bucket(dist)], -1, 1).astype(jnp.float32)
        z = jnp.einsum('bhqd,bhqkd->bhqk', qi, kg).astype(jnp.float32) * scale + bias
        z = jnp.where((dist >= 0)[:, None], z, -jnp.inf)
        p = jax.nn.softmax(z, axis=-1)
        return jnp.einsum('bhqk,bhqkd->bhqd', p.astype(v.dtype), vg)

    starts = jnp.arange(t // Q_BLOCK) * Q_BLOCK
    xs = (seq_blocks(q, 2), seq_blocks(q_idx, 1), seq_blocks(w_idx, 1), starts)
    return from_blocks(lax.map(block, xs))


def differential_attention(q1, q2, k1, k2, v, lam, bias_tab):
    t = q1.shape[2]
    scale = q1.shape[-1] ** -0.5
    kpos = jnp.arange(t)

    def block(args):
        q1i, q2i, s0 = args
        qpos = s0 + jnp.arange(Q_BLOCK)
        dist = qpos[:, None] - kpos[None, :]
        causal = dist >= 0
        bias = jnp.moveaxis(bias_tab[rel_bucket(dist)], -1, 0).astype(jnp.float32)

        def probs(qi, kk):
            z = jnp.einsum('bhqd,bhsd->bhqs', qi, kk).astype(jnp.float32) * scale + bias[None]
            return jax.nn.softmax(jnp.where(causal, z, -jnp.inf), axis=-1)

        a = probs(q1i, k1) - lam * probs(q2i, k2)
        return jnp.einsum('bhqs,bhsd->bhqd', a.astype(v.dtype), v)

    starts = jnp.arange(t // Q_BLOCK) * Q_BLOCK
    return from_blocks(lax.map(block, (seq_blocks(q1, 2), seq_blocks(q2, 2), starts)))


def hybrid_mixer(h, w_in, w_out, diff_lam, diff_g, rel_bias, layer_idx):
    b, t, _ = h.shape
    (qa, ka, va, qb, kb, vb, qc, kc, vc, qx, kx, wx, qd, kd, vd) = jnp.split(h @ w_in, SPLIT_POINTS, axis=-1)

    def heads(a, n):
        return a.reshape(b, t, n, -1).transpose(0, 2, 1, 3)

    def merge(o):
        return o.transpose(0, 2, 1, 3).reshape(b, t, -1)

    bias_b = rel_bias[:, :N_HEADS_B]
    bias_c = rel_bias[:, N_HEADS_B:N_HEADS_B + N_HEADS_C]
    bias_d = rel_bias[:, N_HEADS_B + N_HEADS_C:]

    o_a = stick_breaking_attention(heads(qa, N_HEADS_A), heads(ka, N_HEADS_A), heads(va, N_HEADS_A))
    o_b = dilated_window_attention(heads(qb, N_HEADS_B), heads(kb, N_HEADS_B), heads(vb, N_HEADS_B), bias_b)
    o_c = dsa_attention(heads(qc, N_HEADS_C), heads(kc, N_HEADS_C), heads(vc, N_HEADS_C),
                        qx.reshape(b, t, IDX_HEADS, IDX_DIM), kx, wx, bias_c)

    qd = qd.reshape(b, t, N_HEADS_D, 2, DIFF_QK_DIM)
    kd = kd.reshape(b, t, N_HEADS_D, 2, DIFF_QK_DIM)
    q1, q2 = qd[..., 0, :].transpose(0, 2, 1, 3), qd[..., 1, :].transpose(0, 2, 1, 3)
    k1, k2 = kd[..., 0, :].transpose(0, 2, 1, 3), kd[..., 1, :].transpose(0, 2, 1, 3)
    lamp = diff_lam.astype(jnp.float32)
    lambda_init = 0.8 - 0.6 * math.exp(-0.3 * layer_idx)
    lam = jnp.exp(jnp.sum(lamp[0] * lamp[1])) - jnp.exp(jnp.sum(lamp[2] * lamp[3])) + lambda_init
    o_d = differential_attention(q1, q2, k1, k2, heads(vd, N_HEADS_D), lam, bias_d)
    of = o_d.astype(jnp.float32)
    of = of * lax.rsqrt(jnp.mean(of * of, -1, keepdims=True) + LN_EPS)
    o_d = (of * diff_g.astype(jnp.float32) * (1.0 - lambda_init)).astype(h.dtype)

    merged = jnp.concatenate([merge(o_a), merge(o_b), merge(o_c), merge(o_d)], axis=-1)
    return merged @ w_out


def clamped_swiglu(hh):
    glu, lin = hh[..., ::2], hh[..., 1::2]
    glu = jnp.minimum(glu, SWIGLU_LIMIT)
    lin = jnp.clip(lin, -SWIGLU_LIMIT, SWIGLU_LIMIT)
    return glu * jax.nn.sigmoid(SWIGLU_ALPHA * glu) * (lin + 1.0)


def moe_ffn(h, w_router, b_router, w1, b1, w2, b2):
    b, t, d = h.shape
    hf = h.reshape(-1, d)
    n_tok = hf.shape[0]
    logits = (hf @ w_router + b_router).astype(jnp.float32)
    top_val, top_idx = lax.top_k(logits, TOP_K)
    gate = jax.nn.softmax(top_val, axis=-1)
    e_flat = top_idx.reshape(-1)
    tok_flat = jnp.repeat(jnp.arange(n_tok), TOP_K)
    g_flat = gate.reshape(-1)
    m = e_flat.shape[0]
    order = jnp.argsort(e_flat)
    e_s, tok_s, g_s = e_flat[order], tok_flat[order], g_flat[order]
    counts = jnp.bincount(e_flat, length=N_EXPERTS)
    padded = (counts + MOE_BLOCK - 1) // MOE_BLOCK * MOE_BLOCK
    start = jnp.cumsum(counts) - counts
    pend = jnp.cumsum(padded)
    pstart = pend - padded
    dest = pstart[e_s] + (jnp.arange(m) - start[e_s])
    cap = ((m + MOE_BLOCK - 1) // MOE_BLOCK + N_EXPERTS) * MOE_BLOCK
    n_blocks = cap // MOE_BLOCK
    tok_buf = jnp.zeros((cap,), jnp.int32).at[dest].set(tok_s)
    g_buf = jnp.zeros((cap,), jnp.float32).at[dest].set(g_s)
    blk_expert = jnp.minimum(jnp.searchsorted(pend, jnp.arange(n_blocks) * MOE_BLOCK, side='right'),
                             N_EXPERTS - 1)

    def expert_block(args):
        tok, g, e = args
        xb = hf[tok]
        y = clamped_swiglu(xb @ w1[e] + b1[e]) @ w2[e] + b2[e]
        return y * g[:, None].astype(y.dtype)

    y = lax.map(expert_block, (tok_buf.reshape(n_blocks, MOE_BLOCK), g_buf.reshape(n_blocks, MOE_BLOCK), blk_expert))
    out = jnp.zeros_like(hf).at[tok_buf].add(y.reshape(cap, d))
    return out.reshape(b, t, d)


def setup_inputs(seed: int = 0) -> dict:
    key = jax.random.key(seed)
    ks = jax.random.split(key, 17)

    def nrm(k, shape, scale):
        return jax.random.normal(k, shape, jnp.float32) * scale

    return {
        "x": nrm(ks[0], (BATCH, SEQ, D_MODEL), 1.0),
        "c": nrm(ks[1], (BATCH, D_MODEL), 1.0),
        "w_ada": nrm(ks[2], (DEPTH, D_MODEL, 6 * D_MODEL), 0.1 * D_MODEL ** -0.5),
        "b_ada": nrm(ks[3], (DEPTH, 6 * D_MODEL), 0.02),
        "w_in": nrm(ks[4], (DEPTH, D_MODEL, IN_COLS), D_MODEL ** -0.5),
        "w_out": nrm(ks[5], (DEPTH, MIX_WIDTH, D_MODEL), DEEPNORM_BETA * MIX_WIDTH ** -0.5),
        "diff_lam": nrm(ks[6], (DEPTH, 4, DIFF_QK_DIM), 0.1),
        "diff_g": 1.0 + nrm(ks[7], (DEPTH, HEAD_DIM), 0.02),
        "ln_g": 1.0 + nrm(ks[8], (DEPTH, 2, D_MODEL), 0.02),
        "ln_b": nrm(ks[9], (DEPTH, 2, D_MODEL), 0.02),
        "w_router": nrm(ks[10], (DEPTH, D_MODEL, N_EXPERTS), D_MODEL ** -0.5),
        "b_router": nrm(ks[11], (DEPTH, N_EXPERTS), 0.01),
        "w1": nrm(ks[12], (DEPTH, N_EXPERTS, D_MODEL, 2 * D_FF), D_MODEL ** -0.5),
        "b1": nrm(ks[13], (DEPTH, N_EXPERTS, 2 * D_FF), 0.01),
        "w2": nrm(ks[14], (DEPTH, N_EXPERTS, D_FF, D_MODEL), DEEPNORM_BETA * D_FF ** -0.5),
        "b2": nrm(ks[15], (DEPTH, N_EXPERTS, D_MODEL), 0.01),
        "rel_bias": nrm(ks[16], (N_BUCKETS, N_BIAS_HEADS), 0.5),
    }


def reference(x, c, w_ada, b_ada, w_in, w_out, diff_lam, diff_g, ln_g, ln_b,
              w_router, b_router, w1, b1, w2, b2, rel_bias):
    for l in range(DEPTH):
        mod = (c @ w_ada[l] + b_ada[l])[:, None, :]
        sh1, sc1, g1, sh2, sc2, g2 = jnp.split(mod, 6, axis=-1)
        h = layer_norm(x) * (1.0 + sc1) + sh1
        y = hybrid_mixer(h, w_in[l], w_out[l], diff_lam[l], diff_g[l], rel_bias, l)
        x = layer_norm(DEEPNORM_ALPHA * x + (1.0 + g1) * y, ln_g[l, 0], ln_b[l, 0])
        h = layer_norm(x) * (1.0 + sc2) + sh2
        y = moe_ffn(h, w_router[l], b_router[l], w1[l], b1[l], w2[l], b2[l])
        x = layer_norm(DEEPNORM_ALPHA * x + (1.0 + g2) * y, ln_g[l, 1], ln_b[l, 1])
    return x
```

```cpp
#include <hip/hip_runtime.h>
#include <cstdio>
#include <cstdint>
#include <cmath>

typedef unsigned short bf16_t;
constexpr int D = 1024, NB = 8, T = 4096, M = NB * T, DEPTH = 2;
constexpr int INC = 4176, PP = 4352;
constexpr int QA = 0, KA = 256, VA = 512, QB_ = 768, KB_ = 1024, VB_ = 1280, QC = 1536, KC = 1792, VC = 2048, QX = 2304, KX = 3328, WX = 3392, QD = 3408, KD = 3664, VD = 3920;
constexpr int NE = 32, TOPK = 4, FF = 1024;
constexpr int ROWS_MAX = M * TOPK + NE * 256;
constexpr float LN_EPS = 1e-5f;
constexpr float DN_ALPHA = 1.4142135623730951f;

constexpr size_t MiB = 1u << 20;
constexpr size_t WS_CTL = 0;
constexpr size_t WS_MOD = 1 * MiB;
constexpr size_t WS_TE = 2 * MiB, WS_TP = 2 * MiB + 512 * 1024, WS_TG = 3 * MiB;
constexpr size_t WS_ROWTOK = 4 * MiB;
constexpr size_t WS_MASK = 8 * MiB;
constexpr size_t WS_WIN = 24 * MiB, WS_WOUT = 41 * MiB, WS_W1 = 48 * MiB, WS_W2 = 304 * MiB;
constexpr size_t WS_HN = 432 * MiB, WS_MERGED = 496 * MiB, WS_Y1 = 560 * MiB, WS_X1 = 688 * MiB, WS_XB = 816 * MiB, WS_P = 944 * MiB;
constexpr size_t WS_BIG = 1216 * MiB;
constexpr size_t WS_G = WS_BIG, WS_YP = WS_BIG + 272 * MiB;
constexpr size_t WS_END = 1760 * MiB;
constexpr int C_CNT = 1024;
constexpr int C_OFF = 1152;

__device__ __forceinline__ float bf2f(bf16_t u) { return __uint_as_float(((unsigned)u) << 16); }
__device__ __forceinline__ bf16_t f2bf(float f) { unsigned u = __float_as_uint(f); return (bf16_t)((u + 0x7fffu + ((u >> 16) & 1u)) >> 16); }
__device__ __forceinline__ float wave_sum(float v) {
#pragma unroll
    for (int o = 32; o > 0; o >>= 1) v += __shfl_xor(v, o);
    return v;
}
__device__ __forceinline__ float wave_max(float v) {
#pragma unroll
    for (int o = 32; o > 0; o >>= 1) v = fmaxf(v, __shfl_xor(v, o));
    return v;
}
__device__ __forceinline__ int rel_bucket(int n) {
    if (n < 16) return n < 0 ? 0 : n;
    int b = 16;
    b += (n >= 19) + (n >= 21) + (n >= 24) + (n >= 27) + (n >= 31) + (n >= 35) + (n >= 40) + (n >= 46) + (n >= 52) + (n >= 59) + (n >= 67) + (n >= 77) + (n >= 87) + (n >= 99) + (n >= 113);
    return b;
}
__device__ __forceinline__ float softplusf(float z) { return fmaxf(z, 0.f) + log1pf(__expf(-fabsf(z))); }

__global__ void k_mod(const float* __restrict__ c, const float* __restrict__ w_ada, const float* __restrict__ b_ada, float* __restrict__ MOD) {
    const int j = blockIdx.x * 256 + threadIdx.x, b = blockIdx.y, l = blockIdx.z;
    const float* w = w_ada + (size_t)l * D * 6144;
    float acc = b_ada[l * 6144 + j];
    for (int k = 0; k < D; ++k) acc += c[b * D + k] * w[(size_t)k * 6144 + j];
    MOD[(size_t)(l * NB + b) * 6144 + j] = acc;
}

struct Row { float4 v[4]; };
__device__ __forceinline__ Row row_load(const float* p, int lane) { Row r;
_Pragma("unroll") for (int j = 0; j < 4; ++j) r.v[j] = *(const float4*)(p + 4 * lane + 256 * j); return r; }
__device__ __forceinline__ void row_ln(Row& r) {
    float s = 0.f;
#pragma unroll
    for (int j = 0; j < 4; ++j) s += (r.v[j].x + r.v[j].y) + (r.v[j].z + r.v[j].w);
    const float mean = wave_sum(s) * (1.f / D);
    float q = 0.f;
#pragma unroll
    for (int j = 0; j < 4; ++j) { r.v[j].x -= mean; r.v[j].y -= mean; r.v[j].z -= mean; r.v[j].w -= mean; q += (r.v[j].x * r.v[j].x + r.v[j].y * r.v[j].y) + (r.v[j].z * r.v[j].z + r.v[j].w * r.v[j].w); }
    const float rstd = 1.0f / sqrtf(wave_sum(q) * (1.f / D) + LN_EPS);
#pragma unroll
    for (int j = 0; j < 4; ++j) { r.v[j].x *= rstd; r.v[j].y *= rstd; r.v[j].z *= rstd; r.v[j].w *= rstd; }
}
__device__ __forceinline__ void row_affine(Row& r, const float* g, const float* b, int lane, bool one_plus) {
#pragma unroll
    for (int j = 0; j < 4; ++j) {
        const float4 gv = *(const float4*)(g + 4 * lane + 256 * j), bv = *(const float4*)(b + 4 * lane + 256 * j);
        const float o = one_plus ? 1.f : 0.f;
        r.v[j].x = r.v[j].x * (gv.x + o) + bv.x; r.v[j].y = r.v[j].y * (gv.y + o) + bv.y; r.v[j].z = r.v[j].z * (gv.z + o) + bv.z; r.v[j].w = r.v[j].w * (gv.w + o) + bv.w;
    }
}
__device__ __forceinline__ void row_store_bf16(const Row& r, bf16_t* p, int lane) {
#pragma unroll
    for (int j = 0; j < 4; ++j) { ushort4 o; o.x = f2bf(r.v[j].x); o.y = f2bf(r.v[j].y); o.z = f2bf(r.v[j].z); o.w = f2bf(r.v[j].w); *(ushort4*)(p + 4 * lane + 256 * j) = o; }
}
__device__ __forceinline__ void row_store_f32(const Row& r, float* p, int lane) {
_Pragma("unroll") for (int j = 0; j < 4; ++j) *(float4*)(p + 4 * lane + 256 * j) = r.v[j]; }

__global__ void k_lnmod(const float* __restrict__ x, const float* __restrict__ MOD, int l, bf16_t* __restrict__ HN) {
    const int lane = threadIdx.x & 63, row = blockIdx.x * 4 + (threadIdx.x >> 6), b = row / T;
    const float* mod = MOD + (size_t)(l * NB + b) * 6144;
    Row r = row_load(x + (size_t)row * D, lane);
    row_ln(r); row_affine(r, mod + 1024, mod, lane, true);
    row_store_bf16(r, HN + (size_t)row * D, lane);
}

struct GArgs { const bf16_t* A; const float* W; const float* bias; void* out; const int* rowtok; const int* off; int N; int K; int pad; int pad2; };
static_assert(sizeof(GArgs) == 64, "no padding bytes");
template <int MODE> __global__ void __launch_bounds__(256) k_gemm(GArgs a) {
    __shared__ float As[16][68];
    __shared__ float Bs[16][68];
    const int tid = threadIdx.x, tx = tid & 15, ty = tid >> 4;
    const int row0 = blockIdx.x * 64, n0 = blockIdx.y * 64;
    const float* W = a.W; const float* bias = a.bias;
    if (MODE >= 2) {
        if (row0 >= a.off[NE]) return;
        int e = 0; while (e < NE - 1 && row0 >= a.off[e + 1]) ++e;
        W += (size_t)e * a.K * a.N; bias += (size_t)e * a.N;
    }
    float acc[4][4];
    _Pragma("unroll") for (int i = 0; i < 4; ++i) _Pragma("unroll") for (int j = 0; j < 4; ++j) acc[i][j] = 0.f;
    const int ar = tid >> 2, ak = (tid & 3) * 4;
    size_t arow = (size_t)(row0 + ar);
    if (MODE == 2) arow = (size_t)a.rowtok[row0 + ar];
    const bf16_t* Ap = a.A + arow * a.K + ak;
    const int bk = tid >> 4, bn = (tid & 15) * 4;
    for (int k0 = 0; k0 < a.K; k0 += 16) {
        const ushort4 av = *(const ushort4*)(Ap + k0);
        As[ak + 0][ar] = bf2f(av.x); As[ak + 1][ar] = bf2f(av.y); As[ak + 2][ar] = bf2f(av.z); As[ak + 3][ar] = bf2f(av.w);
        float4 bv = make_float4(0.f, 0.f, 0.f, 0.f);
        if (n0 + bn < a.N) bv = *(const float4*)(W + (size_t)(k0 + bk) * a.N + n0 + bn);
        *(float4*)&Bs[bk][bn] = bv;
        __syncthreads();
#pragma unroll
        for (int k = 0; k < 16; ++k) {
            const float4 x = *(const float4*)&As[k][ty * 4], y = *(const float4*)&Bs[k][tx * 4];
            const float xa[4] = {x.x, x.y, x.z, x.w}, ya[4] = {y.x, y.y, y.z, y.w};
#pragma unroll
            for (int i = 0; i < 4; ++i)
#pragma unroll
                for (int j = 0; j < 4; ++j) acc[i][j] += xa[i] * ya[j];
        }
        __syncthreads();
    }
    const int n = n0 + tx * 4;
    if (n >= a.N) return;
#pragma unroll
    for (int i = 0; i < 4; ++i) {
        const size_t row = (size_t)(row0 + ty * 4 + i);
        if (MODE == 0) { ushort4 o; o.x = f2bf(acc[i][0]); o.y = f2bf(acc[i][1]); o.z = f2bf(acc[i][2]); o.w = f2bf(acc[i][3]); *(ushort4*)((bf16_t*)a.out + row * PP + n) = o; }
        else if (MODE == 1) { *(float4*)((float*)a.out + row * D + n) = make_float4(acc[i][0], acc[i][1], acc[i][2], acc[i][3]); }
        else if (MODE == 2) {
            float v[4];
_Pragma("unroll") for (int j = 0; j < 4; ++j) v[j] = acc[i][j] + bias[n + j];
            float o2[2];
#pragma unroll
            for (int p = 0; p < 2; ++p) { float glu = fminf(v[2 * p], 7.0f), lin = fminf(fmaxf(v[2 * p + 1], -7.0f), 7.0f); o2[p] = glu * (1.0f / (1.0f + __expf(-1.702f * glu))) * (lin + 1.0f); }
            ushort2 o; o.x = f2bf(o2[0]); o.y = f2bf(o2[1]); *(ushort2*)((bf16_t*)a.out + row * FF + n / 2) = o;
        } else { ushort4 o; o.x = f2bf(acc[i][0] + bias[n]); o.y = f2bf(acc[i][1] + bias[n + 1]); o.z = f2bf(acc[i][2] + bias[n + 2]); o.w = f2bf(acc[i][3] + bias[n + 3]); *(ushort4*)((bf16_t*)a.out + row * D + n) = o; }
    }
}

__device__ __forceinline__ void load_row64(const bf16_t* p, float* dst) {
#pragma unroll
    for (int i = 0; i < 8; ++i) { const uint4 u = *(const uint4*)(p + 8 * i); const unsigned w[4] = {u.x, u.y, u.z, u.w};
#pragma unroll
        for (int j = 0; j < 4; ++j) { dst[8 * i + 2 * j] = __uint_as_float(w[j] << 16); dst[8 * i + 2 * j + 1] = __uint_as_float(w[j] & 0xffff0000u); } }
}
__device__ __forceinline__ void store_row64(bf16_t* p, const float* o) {
#pragma unroll
    for (int i = 0; i < 8; ++i) { uint4 u; unsigned w[4];
#pragma unroll
        for (int j = 0; j < 4; ++j) w[j] = (unsigned)f2bf(o[8 * i + 2 * j]) | ((unsigned)f2bf(o[8 * i + 2 * j + 1]) << 16);
        u.x = w[0]; u.y = w[1]; u.z = w[2]; u.w = w[3]; *(uint4*)(p + 8 * i) = u; }
}

__global__ void __launch_bounds__(64) k_attnA(const bf16_t* __restrict__ P, bf16_t* __restrict__ MG) {
    const int lane = threadIdx.x, t0 = blockIdx.x * 64, h = blockIdx.y, b = blockIdx.z, t = t0 + lane;
    const bf16_t* base = P + (size_t)b * T * PP;
    float q[64], o[64], kv[64];
    load_row64(base + (size_t)t * PP + QA + h * 64, q);
#pragma unroll
    for (int i = 0; i < 64; ++i) o[i] = 0.f;
    float S = 0.f;
    for (int s = t0 + 62; s >= 0; --s) {
        load_row64(base + (size_t)s * PP + KA + h * 64, kv);
        float z = 0.f;
#pragma unroll
        for (int i = 0; i < 64; ++i) z += q[i] * kv[i];
        z *= 0.125f;
        const bool valid = s < t;
        const float sp = softplusf(z);
        const float w = valid ? __expf(z - sp - S) : 0.f;
        if (valid) S += sp;
        load_row64(base + (size_t)s * PP + VA + h * 64, kv);
#pragma unroll
        for (int i = 0; i < 64; ++i) o[i] += w * kv[i];
    }
    store_row64(MG + (size_t)(b * T + t) * D + 0 + h * 64, o);
}

__global__ void __launch_bounds__(64) k_attnB(const bf16_t* __restrict__ P, const float* __restrict__ rel_bias, bf16_t* __restrict__ MG) {
    const int lane = threadIdx.x, t0 = blockIdx.x * 64, h = blockIdx.y, b = blockIdx.z, t = t0 + lane;
    const bf16_t* base = P + (size_t)b * T * PP;
    float q[64], o[64], kv[64];
    load_row64(base + (size_t)t * PP + QB_ + h * 64, q);
#pragma unroll
    for (int i = 0; i < 64; ++i) o[i] = 0.f;
    float mx = -INFINITY, l = 0.f;
    for (int cfg = 0; cfg < 3; ++cfg) {
        const int dil = cfg == 0 ? 1 : (cfg == 1 ? 4 : 16);
        for (int m = 0; m <= 128; ++m) {
            const int dist = m * dil, s = t - dist;
            if (s < 0) continue;
            load_row64(base + (size_t)s * PP + KB_ + h * 64, kv);
            float z = 0.f;
#pragma unroll
            for (int i = 0; i < 64; ++i) z += q[i] * kv[i];
            z = z * 0.125f + rel_bias[rel_bucket(dist) * 12 + h];
            const float mn = fmaxf(mx, z), al = __expf(mx - mn), p = __expf(z - mn);
            mx = mn; l = l * al + p;
            load_row64(base + (size_t)s * PP + VB_ + h * 64, kv);
#pragma unroll
            for (int i = 0; i < 64; ++i) o[i] = o[i] * al + p * kv[i];
        }
    }
    const float inv = 1.f / l;
#pragma unroll
    for (int i = 0; i < 64; ++i) o[i] *= inv;
    store_row64(MG + (size_t)(b * T + t) * D + 256 + h * 64, o);
}

__global__ void __launch_bounds__(256) k_idx_scores(const bf16_t* __restrict__ P, float* __restrict__ SC) {
    __shared__ float qs[1024];
    __shared__ float ws[16];
    const int t = blockIdx.x, b = blockIdx.y, tid = threadIdx.x;
    const bf16_t* base = P + (size_t)b * T * PP;
    for (int i = tid; i < 1024; i += 256) qs[i] = bf2f(base[(size_t)t * PP + QX + i]);
    if (tid < 16) ws[tid] = bf2f(base[(size_t)t * PP + WX + tid]) * 0.25f;
    __syncthreads();
    float* out = SC + ((size_t)b * T + t) * T;
    for (int s = tid; s <= t; s += 256) {
        float kx[64];
        load_row64(base + (size_t)s * PP + KX, kx);
        float sc = 0.f;
#pragma unroll
        for (int hh = 0; hh < 16; ++hh) {
            float d = 0.f;
#pragma unroll
            for (int i = 0; i < 64; ++i) d += qs[hh * 64 + i] * kx[i];
            sc += ws[hh] * fmaxf(d * 0.125f, 0.f);
        }
        out[s] = sc;
    }
}
__device__ __forceinline__ unsigned fkey(float f) { const unsigned u = __float_as_uint(f); return (u & 0x80000000u) ? ~u : (u | 0x80000000u); }
__global__ void __launch_bounds__(256) k_select(const float* __restrict__ SC, unsigned* __restrict__ MASK) {
    const int lane = threadIdx.x & 63, row = blockIdx.x * 4 + (threadIdx.x >> 6), t = row % T;
    const float* sc = SC + (size_t)row * T;
    unsigned long long* mrow = (unsigned long long*)(MASK + (size_t)row * 128);
    const int n = t + 1;
    if (n <= 256) {
#pragma unroll
        for (int r = 0; r < 64; ++r) { const int s = r * 64 + lane; const unsigned long long bm = __ballot(s <= t); if (lane == 0) mrow[r] = bm; }
        return;
    }
    unsigned key[64];
    const int nr = (n + 63) >> 6;
#pragma unroll
    for (int r = 0; r < 64; ++r) { const int s = r * 64 + lane; key[r] = (r < nr && s <= t) ? fkey(sc[s]) : 0u; }
    unsigned K = 0u;
    for (int bit = 31; bit >= 0; --bit) {
        const unsigned cand = K | (1u << bit);
        int cnt = 0;
#pragma unroll
        for (int r = 0; r < 64; ++r) cnt += __popcll(__ballot(key[r] >= cand));
        if (cnt >= 256) K = cand;
    }
    int cgt = 0;
#pragma unroll
    for (int r = 0; r < 64; ++r) cgt += __popcll(__ballot(key[r] > K));
    int need = 256 - cgt;
    const unsigned long long lt = (1ull << lane) - 1ull;
#pragma unroll
    for (int r = 0; r < 64; ++r) {
        const unsigned long long gt = __ballot(key[r] > K), eq = __ballot(key[r] == K && K != 0u);
        unsigned long long take = 0ull;
        if (need > 0 && eq) { const bool mine = ((eq >> lane) & 1ull) && (__popcll(eq & lt) < need); take = __ballot(mine); need -= __popcll(take); }
        if (lane == 0) mrow[r] = gt | take;
    }
}
__global__ void __launch_bounds__(64) k_attnC(const bf16_t* __restrict__ P, const unsigned* __restrict__ MASK, const float* __restrict__ rel_bias, bf16_t* __restrict__ MG) {
    const int lane = threadIdx.x, t0 = blockIdx.x * 64, h = blockIdx.y, b = blockIdx.z, t = t0 + lane;
    const bf16_t* base = P + (size_t)b * T * PP;
    const unsigned* mrow = MASK + (size_t)(b * T + t) * 128;
    float q[64], o[64], kv[64];
    load_row64(base + (size_t)t * PP + QC + h * 64, q);
#pragma unroll
    for (int i = 0; i < 64; ++i) o[i] = 0.f;
    float mx = -INFINITY, l = 0.f;
    unsigned mw = 0u;
    for (int s = 0; s <= t0 + 63; ++s) {
        if ((s & 31) == 0) mw = mrow[s >> 5];
        const bool sel = (s <= t) && ((mw >> (s & 31)) & 1u);
        if (!__any(sel)) continue;
        load_row64(base + (size_t)s * PP + KC + h * 64, kv);
        float z = 0.f;
#pragma unroll
        for (int i = 0; i < 64; ++i) z += q[i] * kv[i];
        z = z * 0.125f + rel_bias[rel_bucket(t - s) * 12 + 4 + h];
        float al = 1.f, p = 0.f;
        if (sel) { const float mn = fmaxf(mx, z); al = __expf(mx - mn); p = __expf(z - mn); mx = mn; l = l * al + p; }
        load_row64(base + (size_t)s * PP + VC + h * 64, kv);
#pragma unroll
        for (int i = 0; i < 64; ++i) o[i] = o[i] * al + p * kv[i];
    }
    const float inv = 1.f / l;
#pragma unroll
    for (int i = 0; i < 64; ++i) o[i] *= inv;
    store_row64(MG + (size_t)(b * T + t) * D + 512 + h * 64, o);
}
__global__ void __launch_bounds__(64) k_attnD(const bf16_t* __restrict__ P, const float* __restrict__ rel_bias, const float* __restrict__ diff_lam, const float* __restrict__ diff_g, int l_idx, bf16_t* __restrict__ MG) {
    const int lane = threadIdx.x, t0 = blockIdx.x * 64, h = blockIdx.y, b = blockIdx.z, t = t0 + lane;
    const bf16_t* base = P + (size_t)b * T * PP;
    float q[64], o1[64], o2[64], kv[64];
    load_row64(base + (size_t)t * PP + QD + h * 64, q);
#pragma unroll
    for (int i = 0; i < 64; ++i) { o1[i] = 0.f; o2[i] = 0.f; }
    float m1 = -INFINITY, l1 = 0.f, m2 = -INFINITY, l2 = 0.f;
    const float scale = 0.17677669529663687f;
    for (int s = 0; s <= t0 + 63; ++s) {
        load_row64(base + (size_t)s * PP + KD + h * 64, kv);
        float z1 = 0.f, z2 = 0.f;
#pragma unroll
        for (int i = 0; i < 32; ++i) { z1 += q[i] * kv[i]; z2 += q[32 + i] * kv[32 + i]; }
        const float bias = rel_bias[rel_bucket(t - s) * 12 + 8 + h];
        z1 = z1 * scale + bias; z2 = z2 * scale + bias;
        float a1 = 1.f, p1 = 0.f, a2 = 1.f, p2 = 0.f;
        if (s <= t) {
            float mn = fmaxf(m1, z1); a1 = __expf(m1 - mn); p1 = __expf(z1 - mn); m1 = mn; l1 = l1 * a1 + p1;
            mn = fmaxf(m2, z2); a2 = __expf(m2 - mn); p2 = __expf(z2 - mn); m2 = mn; l2 = l2 * a2 + p2;
        }
        load_row64(base + (size_t)s * PP + VD + h * 64, kv);
#pragma unroll
        for (int i = 0; i < 64; ++i) { o1[i] = o1[i] * a1 + p1 * kv[i]; o2[i] = o2[i] * a2 + p2 * kv[i]; }
    }
    const float* lp = diff_lam + l_idx * 128;
    float s1 = 0.f, s2 = 0.f;
#pragma unroll
    for (int i = 0; i < 32; ++i) { s1 += lp[i] * lp[32 + i]; s2 += lp[64 + i] * lp[96 + i]; }
    const float lam_init = 0.8f - 0.6f * expf(-0.3f * (float)l_idx);
    const float lam = expf(s1) - expf(s2) + lam_init;
    const float i1 = 1.f / l1, i2 = lam / l2;
    float ss = 0.f;
#pragma unroll
    for (int i = 0; i < 64; ++i) { o1[i] = o1[i] * i1 - o2[i] * i2; ss += o1[i] * o1[i]; }
    const float r = 1.0f / sqrtf(ss * (1.f / 64.f) + LN_EPS) * (1.f - lam_init);
#pragma unroll
    for (int i = 0; i < 64; ++i) o1[i] = o1[i] * r * diff_g[l_idx * 64 + i];
    store_row64(MG + (size_t)(b * T + t) * D + 768 + h * 64, o1);
}

__global__ void __launch_bounds__(256) k_post1(const float* __restrict__ x, const float* __restrict__ Y1, const float* __restrict__ MOD, const float* __restrict__ ln_g, const float* __restrict__ ln_b,
                                               const float* __restrict__ w_router, const float* __restrict__ b_router, int l, float* __restrict__ X1, bf16_t* __restrict__ HN,
                                               int* __restrict__ TE, int* __restrict__ TP, float* __restrict__ TG, int* __restrict__ CNT) {
    __shared__ float hs[4][1024];
    const int lane = threadIdx.x & 63, wv = threadIdx.x >> 6, row = blockIdx.x * 4 + wv, b = row / T;
    const float* mod = MOD + (size_t)(l * NB + b) * 6144;
    Row r = row_load(x + (size_t)row * D, lane);
    const Row y = row_load(Y1 + (size_t)row * D, lane);
#pragma unroll
    for (int j = 0; j < 4; ++j) { const float4 g = *(const float4*)(mod + 2048 + 4 * lane + 256 * j);
        r.v[j].x = DN_ALPHA * r.v[j].x + (1.f + g.x) * y.v[j].x; r.v[j].y = DN_ALPHA * r.v[j].y + (1.f + g.y) * y.v[j].y; r.v[j].z = DN_ALPHA * r.v[j].z + (1.f + g.z) * y.v[j].z; r.v[j].w = DN_ALPHA * r.v[j].w + (1.f + g.w) * y.v[j].w; }
    row_ln(r); row_affine(r, ln_g + (l * 2 + 0) * D, ln_b + (l * 2 + 0) * D, lane, false);
    row_store_f32(r, X1 + (size_t)row * D, lane);
    row_ln(r); row_affine(r, mod + 4096, mod + 3072, lane, true);
    row_store_bf16(r, HN + (size_t)row * D, lane);
#pragma unroll
    for (int j = 0; j < 4; ++j) *(float4*)&hs[wv][4 * lane + 256 * j] = r.v[j];
    __syncthreads();
    const int e = lane & 31, half = lane >> 5;
    const float* wr = w_router + (size_t)l * D * NE;
    float acc = 0.f;
    for (int d = half * 512; d < half * 512 + 512; ++d) acc += hs[wv][d] * wr[d * NE + e];
    acc += __shfl_xor(acc, 32);
    float val = (lane < 32) ? acc + b_router[l * NE + e] : -INFINITY;
    float tv[4]; int ti[4];
#pragma unroll
    for (int k = 0; k < 4; ++k) {
        const float m = wave_max(val);
        const unsigned long long bm = __ballot(val == m);
        const int idx = __ffsll((long long)bm) - 1;
        tv[k] = m; ti[k] = idx;
        if (lane == idx) val = -INFINITY;
    }
    float p[4], sum = 0.f;
#pragma unroll
    for (int k = 0; k < 4; ++k) { p[k] = __expf(tv[k] - tv[0]); sum += p[k]; }
    if (lane < 4) {
        const int ee = lane == 0 ? ti[0] : (lane == 1 ? ti[1] : (lane == 2 ? ti[2] : ti[3]));
        const float pp = lane == 0 ? p[0] : (lane == 1 ? p[1] : (lane == 2 ? p[2] : p[3]));
        const int pos = atomicAdd(&CNT[l * NE + ee], 1);
        TE[row * 4 + lane] = ee; TP[row * 4 + lane] = pos; TG[row * 4 + lane] = pp / sum;
    }
}
__global__ void k_offsets(const int* __restrict__ CNT, int* __restrict__ OFF, int l) {
    if (threadIdx.x == 0) { int o = 0; for (int e = 0; e < NE; ++e) { OFF[l * 33 + e] = o; o += (CNT[l * NE + e] + 255) / 256 * 256; } OFF[l * 33 + NE] = o; }
}
__global__ void k_scatter(const int* __restrict__ TE, const int* __restrict__ TP, const int* __restrict__ OFF, int l, int* __restrict__ ROWTOK) {
    const int i = blockIdx.x * 256 + threadIdx.x;
    if (i < M * 4) ROWTOK[OFF[l * 33 + TE[i]] + TP[i]] = i >> 2;
}
__global__ void __launch_bounds__(256) k_final(const float* __restrict__ X1, const bf16_t* __restrict__ YP, const float* __restrict__ MOD, const float* __restrict__ ln_g, const float* __restrict__ ln_b,
                                               const int* __restrict__ TE, const int* __restrict__ TP, const float* __restrict__ TG, const int* __restrict__ OFF, int l, float* __restrict__ out) {
    const int lane = threadIdx.x & 63, row = blockIdx.x * 4 + (threadIdx.x >> 6), b = row / T;
    const float* mod = MOD + (size_t)(l * NB + b) * 6144;
    Row r = row_load(X1 + (size_t)row * D, lane);
    Row y;
_Pragma("unroll") for (int j = 0; j < 4; ++j) y.v[j] = make_float4(0.f, 0.f, 0.f, 0.f);
#pragma unroll
    for (int k = 0; k < 4; ++k) {
        const int rr = OFF[l * 33 + TE[row * 4 + k]] + TP[row * 4 + k]; const float g = TG[row * 4 + k];
        const bf16_t* yp = YP + (size_t)rr * D;
#pragma unroll
        for (int j = 0; j < 4; ++j) { const ushort4 u = *(const ushort4*)(yp + 4 * lane + 256 * j); y.v[j].x += g * bf2f(u.x); y.v[j].y += g * bf2f(u.y); y.v[j].z += g * bf2f(u.z); y.v[j].w += g * bf2f(u.w); }
    }
#pragma unroll
    for (int j = 0; j < 4; ++j) { const float4 g = *(const float4*)(mod + 5120 + 4 * lane + 256 * j);
        r.v[j].x = DN_ALPHA * r.v[j].x + (1.f + g.x) * y.v[j].x; r.v[j].y = DN_ALPHA * r.v[j].y + (1.f + g.y) * y.v[j].y; r.v[j].z = DN_ALPHA * r.v[j].z + (1.f + g.z) * y.v[j].z; r.v[j].w = DN_ALPHA * r.v[j].w + (1.f + g.w) * y.v[j].w; }
    row_ln(r); row_affine(r, ln_g + (l * 2 + 1) * D, ln_b + (l * 2 + 1) * D, lane, false);
    row_store_f32(r, out + (size_t)row * D, lane);
}

extern "C" void kernel_launch(void* const* d_in, const int* in_sizes, int n_in, void* d_out, int out_size, void* d_ws, size_t ws_size, hipStream_t stream) {
    if (n_in != 17 || out_size != M * D || ws_size < WS_END) { fprintf(stderr, "kernel_launch: unexpected arguments (n_in %d, out %d, ws %zu)\n", n_in, out_size, ws_size); return; }
    const float* x = (const float*)d_in[0]; const float* c = (const float*)d_in[1]; const float* w_ada = (const float*)d_in[2]; const float* b_ada = (const float*)d_in[3];
    const float* w_in = (const float*)d_in[4]; const float* w_out = (const float*)d_in[5]; const float* diff_lam = (const float*)d_in[6]; const float* diff_g = (const float*)d_in[7];
    const float* ln_g = (const float*)d_in[8]; const float* ln_b = (const float*)d_in[9]; const float* w_router = (const float*)d_in[10]; const float* b_router = (const float*)d_in[11];
    const float* w1 = (const float*)d_in[12]; const float* b1 = (const float*)d_in[13]; const float* w2 = (const float*)d_in[14]; const float* b2 = (const float*)d_in[15]; const float* rel_bias = (const float*)d_in[16];
    unsigned char* ws = (unsigned char*)d_ws;
    int* CTL = (int*)(ws + WS_CTL); float* MOD = (float*)(ws + WS_MOD);
    int* TE = (int*)(ws + WS_TE); int* TP = (int*)(ws + WS_TP); float* TG = (float*)(ws + WS_TG); int* ROWTOK = (int*)(ws + WS_ROWTOK);
    unsigned* MASK = (unsigned*)(ws + WS_MASK);
    bf16_t* HN = (bf16_t*)(ws + WS_HN); bf16_t* MG = (bf16_t*)(ws + WS_MERGED); float* Y1 = (float*)(ws + WS_Y1); float* X1 = (float*)(ws + WS_X1); float* XB = (float*)(ws + WS_XB);
    bf16_t* P = (bf16_t*)(ws + WS_P); float* SC = (float*)(ws + WS_BIG); bf16_t* G = (bf16_t*)(ws + WS_G); bf16_t* YP = (bf16_t*)(ws + WS_YP);
    (void)hipMemsetAsync(ws + WS_CTL, 0, 1 * MiB, stream);
    k_mod<<<dim3(24, NB, DEPTH), 256, 0, stream>>>(c, w_ada, b_ada, MOD);
    for (int l = 0; l < DEPTH; ++l) {
        const float* xin = l == 0 ? x : XB; float* xout = l == DEPTH - 1 ? (float*)d_out : XB;
        k_lnmod<<<M / 4, 256, 0, stream>>>(xin, MOD, l, HN);
        { GArgs a{HN, w_in + (size_t)l * D * INC, nullptr, P, nullptr, nullptr, INC, D, 0}; k_gemm<0><<<dim3(M / 64, (INC + 63) / 64), 256, 0, stream>>>(a); }
        k_attnA<<<dim3(T / 64, 4, NB), 64, 0, stream>>>(P, MG);
        k_attnB<<<dim3(T / 64, 4, NB), 64, 0, stream>>>(P, rel_bias, MG);
        k_idx_scores<<<dim3(T, NB), 256, 0, stream>>>(P, SC);
        k_select<<<M / 4, 256, 0, stream>>>(SC, MASK);
        k_attnC<<<dim3(T / 64, 4, NB), 64, 0, stream>>>(P, MASK, rel_bias, MG);
        k_attnD<<<dim3(T / 64, 4, NB), 64, 0, stream>>>(P, rel_bias, diff_lam, diff_g, l, MG);
        { GArgs a{MG, w_out + (size_t)l * D * D, nullptr, Y1, nullptr, nullptr, D, D, 0}; k_gemm<1><<<dim3(M / 64, D / 64), 256, 0, stream>>>(a); }
        k_post1<<<M / 4, 256, 0, stream>>>(xin, Y1, MOD, ln_g, ln_b, w_router, b_router, l, X1, HN, TE, TP, TG, CTL + C_CNT);
        k_offsets<<<1, 64, 0, stream>>>(CTL + C_CNT, CTL + C_OFF, l);
        (void)hipMemsetAsync(ROWTOK, 0, (size_t)ROWS_MAX * 4, stream);
        k_scatter<<<M * 4 / 256, 256, 0, stream>>>(TE, TP, CTL + C_OFF, l, ROWTOK);
        { GArgs a{HN, w1 + (size_t)l * NE * D * 2 * FF, b1 + (size_t)l * NE * 2 * FF, G, ROWTOK, CTL + C_OFF + l * 33, 2 * FF, D, 0}; k_gemm<2><<<dim3(ROWS_MAX / 64, 2 * FF / 64), 256, 0, stream>>>(a); }
        { GArgs a{G, w2 + (size_t)l * NE * FF * D, b2 + (size_t)l * NE * D, YP, nullptr, CTL + C_OFF + l * 33, D, FF, 0}; k_gemm<3><<<dim3(ROWS_MAX / 64, D / 64), 256, 0, stream>>>(a); }
        k_final<<<M / 4, 256, 0, stream>>>(X1, YP, MOD, ln_g, ln_b, TE, TP, TG, CTL + C_OFF, l, xout);
    }
}
```

```cpp
#include <hip/hip_runtime.h>
#include <cstdio>
#include <cstdint>
#include <cmath>

typedef unsigned short bf16_t;
constexpr int D = 1024, NB = 8, T = 4096, M = NB * T, DEPTH = 2;
constexpr int INC = 4176, PP = 4352;
constexpr int QA = 0, KA = 256, VA = 512, QB_ = 768, KB_ = 1024, VB_ = 1280, QC = 1536, KC = 1792, VC = 2048, QX = 2304, KX = 3328, WX = 3392, QD = 3408, KD = 3664, VD = 3920;
constexpr int NE = 32, TOPK = 4, FF = 1024;
constexpr int NSLOT = M * TOPK;
constexpr int LCAP = M;
constexpr float LN_EPS = 1e-5f;
constexpr float DN_ALPHA = 1.4142135623730951f;
constexpr float LOG2E = 1.4426950408889634f;

constexpr size_t MiB = 1u << 20;
constexpr size_t WS_CTL = 0;
constexpr size_t WS_MOD = 1 * MiB;
constexpr size_t WS_TE = 2 * MiB, WS_TG = 3 * MiB;
constexpr size_t WS_LIST = 4 * MiB;
constexpr size_t WS_MASK = 8 * MiB;
constexpr size_t WS_MODP = 24 * MiB;
constexpr size_t WS_WIN = 28 * MiB, WS_WOUT = 45 * MiB, WS_W1 = 50 * MiB, WS_W2 = 306 * MiB;
constexpr size_t WS_HN = 434 * MiB, WS_MERGED = 498 * MiB, WS_Y1 = 562 * MiB, WS_X1 = 626 * MiB, WS_XB = 754 * MiB, WS_P = 882 * MiB;
constexpr size_t WS_BIG = 1154 * MiB;
constexpr size_t WS_G = WS_BIG, WS_YP = WS_BIG + 256 * MiB;
constexpr size_t WS_END = 1666 * MiB;
constexpr int CW_TMO = 0;
constexpr int C_CNT = 1024;
constexpr int CW_BAR = 4096;

#define DI __device__ __forceinline__
DI int opaque_tid() { int t = threadIdx.x; asm volatile("" : "+v"(t)); return t; }
DI float bf2f(bf16_t u) { return __uint_as_float(((unsigned)u) << 16); }
DI bf16_t f2bf(float f) { unsigned u = __float_as_uint(f); return (bf16_t)((u + 0x7fffu + ((u >> 16) & 1u)) >> 16); }
DI unsigned pk2(float lo, float hi) { return (unsigned)f2bf(lo) | ((unsigned)f2bf(hi) << 16); }
DI float wave_sum(float v) {
#pragma unroll
    for (int o = 32; o > 0; o >>= 1) v += __shfl_xor(v, o);
    return v;
}
DI float wave_max(float v) {
#pragma unroll
    for (int o = 32; o > 0; o >>= 1) v = fmaxf(v, __shfl_xor(v, o));
    return v;
}
DI int rel_bucket(int n) {
    if (n < 16) return n < 0 ? 0 : n;
    int b = 16;
    b += (n >= 19) + (n >= 21) + (n >= 24) + (n >= 27) + (n >= 31) + (n >= 35) + (n >= 40) + (n >= 46) + (n >= 52) + (n >= 59) + (n >= 67) + (n >= 77) + (n >= 87) + (n >= 99) + (n >= 113);
    return b;
}
DI float softplusf(float z) { return fmaxf(z, 0.f) + log1pf(__expf(-fabsf(z))); }

struct Row { float4 v[4]; };
DI Row row_load(const float* p, int lane) { Row r;
    _Pragma("unroll") for (int j = 0; j < 4; ++j) r.v[j] = *(const float4*)(p + 4 * lane + 256 * j);
    return r; }
DI Row row_load_bf16(const bf16_t* p, int lane) { Row r;
    _Pragma("unroll") for (int j = 0; j < 4; ++j) { const ushort4 u = *(const ushort4*)(p + 4 * lane + 256 * j); r.v[j] = make_float4(bf2f(u.x), bf2f(u.y), bf2f(u.z), bf2f(u.w)); }
    return r; }
DI void row_ln(Row& r) {
    float s = 0.f;
    _Pragma("unroll") for (int j = 0; j < 4; ++j) s += (r.v[j].x + r.v[j].y) + (r.v[j].z + r.v[j].w);
    const float mean = wave_sum(s) * (1.f / D);
    float q = 0.f;
    _Pragma("unroll") for (int j = 0; j < 4; ++j) { r.v[j].x -= mean; r.v[j].y -= mean; r.v[j].z -= mean; r.v[j].w -= mean; q += (r.v[j].x * r.v[j].x + r.v[j].y * r.v[j].y) + (r.v[j].z * r.v[j].z + r.v[j].w * r.v[j].w); }
    const float rstd = 1.0f / sqrtf(wave_sum(q) * (1.f / D) + LN_EPS);
    _Pragma("unroll") for (int j = 0; j < 4; ++j) { r.v[j].x *= rstd; r.v[j].y *= rstd; r.v[j].z *= rstd; r.v[j].w *= rstd; }
}
DI void row_affine(Row& r, const float* g, const float* b, int lane, bool one_plus) {
    const float o = one_plus ? 1.f : 0.f;
    _Pragma("unroll") for (int j = 0; j < 4; ++j) {
        const float4 gv = *(const float4*)(g + 4 * lane + 256 * j), bv = *(const float4*)(b + 4 * lane + 256 * j);
        r.v[j].x = r.v[j].x * (gv.x + o) + bv.x; r.v[j].y = r.v[j].y * (gv.y + o) + bv.y; r.v[j].z = r.v[j].z * (gv.z + o) + bv.z; r.v[j].w = r.v[j].w * (gv.w + o) + bv.w;
    }
}
DI void row_resid(Row& r, const Row& y, const float* g, int lane) {
    _Pragma("unroll") for (int j = 0; j < 4; ++j) { const float4 gv = *(const float4*)(g + 4 * lane + 256 * j);
        r.v[j].x = DN_ALPHA * r.v[j].x + (1.f + gv.x) * y.v[j].x; r.v[j].y = DN_ALPHA * r.v[j].y + (1.f + gv.y) * y.v[j].y; r.v[j].z = DN_ALPHA * r.v[j].z + (1.f + gv.z) * y.v[j].z; r.v[j].w = DN_ALPHA * r.v[j].w + (1.f + gv.w) * y.v[j].w; }
}
DI void row_store_bf16(const Row& r, bf16_t* p, int lane) {
    _Pragma("unroll") for (int j = 0; j < 4; ++j) { uint2 o; o.x = pk2(r.v[j].x, r.v[j].y); o.y = pk2(r.v[j].z, r.v[j].w); *(uint2*)(p + 4 * lane + 256 * j) = o; }
}
DI void row_store_f32(const Row& r, float* p, int lane) {
    _Pragma("unroll") for (int j = 0; j < 4; ++j) *(float4*)(p + 4 * lane + 256 * j) = r.v[j]; }

template <class HP> DI void router_top4(HP hs, const float* wr  , const float* br  , int lane, int& e4, float& g4) {
    const int e = lane & 31, half = lane >> 5;
    float acc = 0.f;
    for (int d = half * 512; d < half * 512 + 512; ++d) acc += hs[d] * wr[d * NE + e];
    acc += __shfl_xor(acc, 32);
    float val = (lane < 32) ? acc + br[e] : -INFINITY;
    float tv0 = 0.f, tvk = 0.f, sum = 0.f; int tik = 0;
#pragma unroll
    for (int k = 0; k < 4; ++k) {
        const float m = wave_max(val);
        const unsigned long long bm = __ballot(val == m);
        const int idx = __ffsll((long long)bm) - 1;
        if (k == 0) tv0 = m;
        const float p = __expf(m - tv0); sum += p;
        if (lane == k) { tvk = p; tik = idx; }
        if (lane == idx) val = -INFINITY;
    }
    e4 = tik; g4 = tvk / sum;
}

__global__ void k_mod(const float* __restrict__ c, const float* __restrict__ w_ada, const float* __restrict__ b_ada, float* __restrict__ MOD) {
    const int j = blockIdx.x * 256 + threadIdx.x, b = blockIdx.y, l = blockIdx.z;
    const float* w = w_ada + (size_t)l * D * 6144;
    float acc = b_ada[l * 6144 + j];
    for (int k = 0; k < D; ++k) acc += c[b * D + k] * w[(size_t)k * 6144 + j];
    MOD[(size_t)(l * NB + b) * 6144 + j] = acc;
}
__global__ void k_lnmod(const float* __restrict__ x, const float* __restrict__ MOD, int l, bf16_t* __restrict__ HN) {
    const int lane = threadIdx.x & 63, row = blockIdx.x * 4 + (threadIdx.x >> 6), b = row / T;
    const float* mod = MOD + (size_t)(l * NB + b) * 6144;
    Row r = row_load(x + (size_t)row * D, lane);
    row_ln(r); row_affine(r, mod + 1024, mod, lane, true);
    row_store_bf16(r, HN + (size_t)row * D, lane);
}
struct GArgs { const bf16_t* A; const float* W; const float* bias; bf16_t* out; const int* list; const int* cnt; int N; int K; int pad; int pad2; };
static_assert(sizeof(GArgs) == 64, "no padding bytes");
template <int MODE> __global__ void __launch_bounds__(256) k_gemm(GArgs a) {
    __shared__ float As[16][68];
    __shared__ float Bs[16][68];
    __shared__ int slots[64];
    const int tid = threadIdx.x, tx = tid & 15, ty = tid >> 4;
    const int row0 = blockIdx.x * 64, n0 = blockIdx.y * 64;
    const float* W = a.W; const float* bias = a.bias;
    int nvalid = 64;
    if (MODE >= 2) {
        const int e = blockIdx.z, cnt = a.cnt[e];
        if (row0 >= cnt) return;
        nvalid = min(64, cnt - row0);
        W += (size_t)e * a.K * a.N; bias += (size_t)e * a.N;
        if (tid < 64) slots[tid] = tid < nvalid ? a.list[e * LCAP + row0 + tid] : 0;
        __syncthreads();
    }
    float acc[4][4];
    _Pragma("unroll") for (int i = 0; i < 4; ++i) _Pragma("unroll") for (int j = 0; j < 4; ++j) acc[i][j] = 0.f;
    const int ar = tid >> 2, ak = (tid & 3) * 4;
    size_t arow = (size_t)(row0 + ar);
    if (MODE == 2) arow = (size_t)(slots[ar] >> 2);
    if (MODE == 3) arow = (size_t)slots[ar];
    const bf16_t* Ap = a.A + arow * a.K + ak;
    const int bk = tid >> 4, bn = (tid & 15) * 4;
    for (int k0 = 0; k0 < a.K; k0 += 16) {
        const ushort4 av = *(const ushort4*)(Ap + k0);
        As[ak + 0][ar] = bf2f(av.x); As[ak + 1][ar] = bf2f(av.y); As[ak + 2][ar] = bf2f(av.z); As[ak + 3][ar] = bf2f(av.w);
        float4 bv = make_float4(0.f, 0.f, 0.f, 0.f);
        if (n0 + bn < a.N) bv = *(const float4*)(W + (size_t)(k0 + bk) * a.N + n0 + bn);
        *(float4*)&Bs[bk][bn] = bv;
        __syncthreads();
#pragma unroll
        for (int k = 0; k < 16; ++k) {
            const float4 x = *(const float4*)&As[k][ty * 4], y = *(const float4*)&Bs[k][tx * 4];
            const float xa[4] = {x.x, x.y, x.z, x.w}, ya[4] = {y.x, y.y, y.z, y.w};
#pragma unroll
            for (int i = 0; i < 4; ++i)
#pragma unroll
                for (int j = 0; j < 4; ++j) acc[i][j] += xa[i] * ya[j];
        }
        __syncthreads();
    }
    const int n = n0 + tx * 4;
    if (n >= a.N) return;
#pragma unroll
    for (int i = 0; i < 4; ++i) {
        const int rl = ty * 4 + i;
        if (rl >= nvalid) continue;
        size_t row = (size_t)(row0 + rl);
        if (MODE >= 2) row = (size_t)slots[rl];
        if (MODE == 0) { uint2 o; o.x = pk2(acc[i][0], acc[i][1]); o.y = pk2(acc[i][2], acc[i][3]); *(uint2*)(a.out + row * PP + n) = o; }
        else if (MODE == 1) { uint2 o; o.x = pk2(acc[i][0], acc[i][1]); o.y = pk2(acc[i][2], acc[i][3]); *(uint2*)(a.out + row * D + n) = o; }
        else if (MODE == 2) {
            float v[4];
            _Pragma("unroll") for (int j = 0; j < 4; ++j) v[j] = acc[i][j] + bias[n + j];
            float o2[2];
            _Pragma("unroll") for (int p = 0; p < 2; ++p) { float glu = fminf(v[2 * p], 7.0f), lin = fminf(fmaxf(v[2 * p + 1], -7.0f), 7.0f); o2[p] = glu * (1.0f / (1.0f + __expf(-1.702f * glu))) * (lin + 1.0f); }
            *(unsigned*)(a.out + row * FF + n / 2) = pk2(o2[0], o2[1]);
        } else { uint2 o; o.x = pk2(acc[i][0] + bias[n], acc[i][1] + bias[n + 1]); o.y = pk2(acc[i][2] + bias[n + 2], acc[i][3] + bias[n + 3]); *(uint2*)(a.out + row * D + n) = o; }
    }
}

DI void load_row64(const bf16_t* p, float* dst) {
#pragma unroll
    for (int i = 0; i < 8; ++i) { const uint4 u = *(const uint4*)(p + 8 * i); const unsigned w[4] = {u.x, u.y, u.z, u.w};
#pragma unroll
        for (int j = 0; j < 4; ++j) { dst[8 * i + 2 * j] = __uint_as_float(w[j] << 16); dst[8 * i + 2 * j + 1] = __uint_as_float(w[j] & 0xffff0000u); } }
}
DI void store_row64(bf16_t* p, const float* o) {
#pragma unroll
    for (int i = 0; i < 8; ++i) { uint4 u; unsigned w[4];
#pragma unroll
        for (int j = 0; j < 4; ++j) w[j] = pk2(o[8 * i + 2 * j], o[8 * i + 2 * j + 1]);
        u.x = w[0]; u.y = w[1]; u.z = w[2]; u.w = w[3]; *(uint4*)(p + 8 * i) = u; }
}
__global__ void __launch_bounds__(64) k_attnA(const bf16_t* __restrict__ P, bf16_t* __restrict__ MG) {
    const int lane = threadIdx.x, t0 = blockIdx.x * 64, h = blockIdx.y, b = blockIdx.z, t = t0 + lane;
    const bf16_t* base = P + (size_t)b * T * PP;
    float q[64], o[64], kv[64];
    load_row64(base + (size_t)t * PP + QA + h * 64, q);
    _Pragma("unroll") for (int i = 0; i < 64; ++i) o[i] = 0.f;
    float S = 0.f;
    for (int s = t0 + 62; s >= 0; --s) {
        load_row64(base + (size_t)s * PP + KA + h * 64, kv);
        float z = 0.f;
        _Pragma("unroll") for (int i = 0; i < 64; ++i) z += q[i] * kv[i];
        z *= 0.125f;
        const bool valid = s < t;
        const float sp = softplusf(z);
        const float w = valid ? __expf(z - sp - S) : 0.f;
        if (valid) S += sp;
        load_row64(base + (size_t)s * PP + VA + h * 64, kv);
        _Pragma("unroll") for (int i = 0; i < 64; ++i) o[i] += w * kv[i];
    }
    store_row64(MG + (size_t)(b * T + t) * D + 0 + h * 64, o);
}
__global__ void __launch_bounds__(64) k_attnB(const bf16_t* __restrict__ P, const float* __restrict__ rel_bias, bf16_t* __restrict__ MG) {
    const int lane = threadIdx.x, t0 = blockIdx.x * 64, h = blockIdx.y, b = blockIdx.z, t = t0 + lane;
    const bf16_t* base = P + (size_t)b * T * PP;
    float q[64], o[64], kv[64];
    load_row64(base + (size_t)t * PP + QB_ + h * 64, q);
    _Pragma("unroll") for (int i = 0; i < 64; ++i) o[i] = 0.f;
    float mx = -INFINITY, l = 0.f;
    for (int cfg = 0; cfg < 3; ++cfg) {
        const int dil = cfg == 0 ? 1 : (cfg == 1 ? 4 : 16);
        for (int m = 0; m <= 128; ++m) {
            const int dist = m * dil, s = t - dist;
            if (s < 0) continue;
            load_row64(base + (size_t)s * PP + KB_ + h * 64, kv);
            float z = 0.f;
            _Pragma("unroll") for (int i = 0; i < 64; ++i) z += q[i] * kv[i];
            z = z * 0.125f + rel_bias[rel_bucket(dist) * 12 + h];
            const float mn = fmaxf(mx, z), al = __expf(mx - mn), p = __expf(z - mn);
            mx = mn; l = l * al + p;
            load_row64(base + (size_t)s * PP + VB_ + h * 64, kv);
            _Pragma("unroll") for (int i = 0; i < 64; ++i) o[i] = o[i] * al + p * kv[i];
        }
    }
    const float inv = 1.f / l;
    _Pragma("unroll") for (int i = 0; i < 64; ++i) o[i] *= inv;
    store_row64(MG + (size_t)(b * T + t) * D + 256 + h * 64, o);
}
__global__ void __launch_bounds__(256) k_idx_scores(const bf16_t* __restrict__ P, float* __restrict__ SC) {
    __shared__ float qs[1024];
    __shared__ float ws[16];
    const int t = blockIdx.x, b = blockIdx.y, tid = threadIdx.x;
    const bf16_t* base = P + (size_t)b * T * PP;
    for (int i = tid; i < 1024; i += 256) qs[i] = bf2f(base[(size_t)t * PP + QX + i]);
    if (tid < 16) ws[tid] = bf2f(base[(size_t)t * PP + WX + tid]) * 0.25f;
    __syncthreads();
    float* out = SC + ((size_t)b * T + t) * T;
    for (int s = tid; s <= t; s += 256) {
        float kx[64];
        load_row64(base + (size_t)s * PP + KX, kx);
        float sc = 0.f;
        _Pragma("unroll") for (int hh = 0; hh < 16; ++hh) {
            float d = 0.f;
            _Pragma("unroll") for (int i = 0; i < 64; ++i) d += qs[hh * 64 + i] * kx[i];
            sc += ws[hh] * fmaxf(d * 0.125f, 0.f);
        }
        out[s] = sc;
    }
}
DI unsigned fkey(float f) { const unsigned u = __float_as_uint(f); return (u & 0x80000000u) ? ~u : (u | 0x80000000u); }
DI void select_row(const float* __restrict__ sc, unsigned long long* __restrict__ mrow, int t, int lane) {
    const int n = t + 1;
    if (n <= 256) {
        _Pragma("unroll") for (int r = 0; r < 64; ++r) { const int s = r * 64 + lane; const unsigned long long bm = __ballot(s <= t); if (lane == 0) mrow[r] = bm; }
        return;
    }
    unsigned key[64];
    const int nr = (n + 63) >> 6;
    _Pragma("unroll") for (int r = 0; r < 64; ++r) { const int s = r * 64 + lane; key[r] = (r < nr && s <= t) ? fkey(sc[s]) : 0u; }
    unsigned K = 0u;
    for (int bit = 31; bit >= 0; --bit) {
        const unsigned cand = K | (1u << bit);
        int cnt = 0;
        _Pragma("unroll") for (int r = 0; r < 64; ++r) cnt += __popcll(__ballot(key[r] >= cand));
        if (cnt >= 256) K = cand;
    }
    int cgt = 0;
    _Pragma("unroll") for (int r = 0; r < 64; ++r) cgt += __popcll(__ballot(key[r] > K));
    int need = 256 - cgt;
    const unsigned long long lt = (1ull << lane) - 1ull;
    _Pragma("unroll") for (int r = 0; r < 64; ++r) {
        const unsigned long long gt = __ballot(key[r] > K), eq = __ballot(key[r] == K && K != 0u);
        unsigned long long take = 0ull;
        if (need > 0 && eq) { const bool mine = ((eq >> lane) & 1ull) && (__popcll(eq & lt) < need); take = __ballot(mine); need -= __popcll(take); }
        if (lane == 0) mrow[r] = gt | take;
    }
}
__global__ void __launch_bounds__(256) k_select(const float* __restrict__ SC, unsigned* __restrict__ MASK) {
    const int lane = threadIdx.x & 63, row = blockIdx.x * 4 + (threadIdx.x >> 6), t = row % T;
    select_row(SC + (size_t)row * T, (unsigned long long*)(MASK + (size_t)row * 128), t, lane);
}
__global__ void __launch_bounds__(64) k_attnC(const bf16_t* __restrict__ P, const unsigned* __restrict__ MASK, const float* __restrict__ rel_bias, bf16_t* __restrict__ MG) {
    const int lane = threadIdx.x, t0 = blockIdx.x * 64, h = blockIdx.y, b = blockIdx.z, t = t0 + lane;
    const bf16_t* base = P + (size_t)b * T * PP;
    const unsigned* mrow = MASK + (size_t)(b * T + t) * 128;
    float q[64], o[64], kv[64];
    load_row64(base + (size_t)t * PP + QC + h * 64, q);
    _Pragma("unroll") for (int i = 0; i < 64; ++i) o[i] = 0.f;
    float mx = -INFINITY, l = 0.f;
    unsigned mw = 0u;
    for (int s = 0; s <= t0 + 63; ++s) {
        if ((s & 31) == 0) mw = mrow[s >> 5];
        const bool sel = (s <= t) && ((mw >> (s & 31)) & 1u);
        if (!__any(sel)) continue;
        load_row64(base + (size_t)s * PP + KC + h * 64, kv);
        float z = 0.f;
        _Pragma("unroll") for (int i = 0; i < 64; ++i) z += q[i] * kv[i];
        z = z * 0.125f + rel_bias[rel_bucket(t - s) * 12 + 4 + h];
        float al = 1.f, p = 0.f;
        if (sel) { const float mn = fmaxf(mx, z); al = __expf(mx - mn); p = __expf(z - mn); mx = mn; l = l * al + p; }
        load_row64(base + (size_t)s * PP + VC + h * 64, kv);
        _Pragma("unroll") for (int i = 0; i < 64; ++i) o[i] = o[i] * al + p * kv[i];
    }
    const float inv = 1.f / l;
    _Pragma("unroll") for (int i = 0; i < 64; ++i) o[i] *= inv;
    store_row64(MG + (size_t)(b * T + t) * D + 512 + h * 64, o);
}
__global__ void __launch_bounds__(64) k_attnD(const bf16_t* __restrict__ P, const float* __restrict__ rel_bias, const float* __restrict__ diff_lam, const float* __restrict__ diff_g, int l_idx, bf16_t* __restrict__ MG) {
    const int lane = threadIdx.x, t0 = blockIdx.x * 64, h = blockIdx.y, b = blockIdx.z, t = t0 + lane;
    const bf16_t* base = P + (size_t)b * T * PP;
    float q[64], o1[64], o2[64], kv[64];
    load_row64(base + (size_t)t * PP + QD + h * 64, q);
    _Pragma("unroll") for (int i = 0; i < 64; ++i) { o1[i] = 0.f; o2[i] = 0.f; }
    float m1 = -INFINITY, l1 = 0.f, m2 = -INFINITY, l2 = 0.f;
    const float scale = 0.17677669529663687f;
    for (int s = 0; s <= t0 + 63; ++s) {
        load_row64(base + (size_t)s * PP + KD + h * 64, kv);
        float z1 = 0.f, z2 = 0.f;
        _Pragma("unroll") for (int i = 0; i < 32; ++i) { z1 += q[i] * kv[i]; z2 += q[32 + i] * kv[32 + i]; }
        const float bias = rel_bias[rel_bucket(t - s) * 12 + 8 + h];
        z1 = z1 * scale + bias; z2 = z2 * scale + bias;
        float a1 = 1.f, p1 = 0.f, a2 = 1.f, p2 = 0.f;
        if (s <= t) {
            float mn = fmaxf(m1, z1); a1 = __expf(m1 - mn); p1 = __expf(z1 - mn); m1 = mn; l1 = l1 * a1 + p1;
            mn = fmaxf(m2, z2); a2 = __expf(m2 - mn); p2 = __expf(z2 - mn); m2 = mn; l2 = l2 * a2 + p2;
        }
        load_row64(base + (size_t)s * PP + VD + h * 64, kv);
        _Pragma("unroll") for (int i = 0; i < 64; ++i) { o1[i] = o1[i] * a1 + p1 * kv[i]; o2[i] = o2[i] * a2 + p2 * kv[i]; }
    }
    const float* lp = diff_lam + l_idx * 128;
    float s1 = 0.f, s2 = 0.f;
    for (int i = 0; i < 32; ++i) { s1 += lp[i] * lp[32 + i]; s2 += lp[64 + i] * lp[96 + i]; }
    const float lam_init = 0.8f - 0.6f * expf(-0.3f * (float)l_idx);
    const float lam = expf(s1) - expf(s2) + lam_init;
    const float i1 = 1.f / l1, i2 = lam / l2;
    float ss = 0.f;
    _Pragma("unroll") for (int i = 0; i < 64; ++i) { o1[i] = o1[i] * i1 - o2[i] * i2; ss += o1[i] * o1[i]; }
    const float r = 1.0f / sqrtf(ss * (1.f / 64.f) + LN_EPS) * (1.f - lam_init);
    _Pragma("unroll") for (int i = 0; i < 64; ++i) o1[i] = o1[i] * r * diff_g[l_idx * 64 + i];
    store_row64(MG + (size_t)(b * T + t) * D + 768 + h * 64, o1);
}
__global__ void __launch_bounds__(256) k_post1(const float* __restrict__ x, const bf16_t* __restrict__ Y1, const float* __restrict__ MOD, const float* __restrict__ ln_g, const float* __restrict__ ln_b,
                                               const float* __restrict__ w_router, const float* __restrict__ b_router, int l, float* __restrict__ X1, bf16_t* __restrict__ HN,
                                               int* __restrict__ TE, float* __restrict__ TG, int* __restrict__ CNT, int* __restrict__ LIST) {
    __shared__ float hs[4][1024];
    const int lane = threadIdx.x & 63, wv = threadIdx.x >> 6, row = blockIdx.x * 4 + wv, b = row / T;
    const float* mod = MOD + (size_t)(l * NB + b) * 6144;
    Row r = row_load(x + (size_t)row * D, lane);
    const Row y = row_load_bf16(Y1 + (size_t)row * D, lane);
    row_resid(r, y, mod + 2048, lane);
    row_ln(r); row_affine(r, ln_g + (l * 2 + 0) * D, ln_b + (l * 2 + 0) * D, lane, false);
    row_store_f32(r, X1 + (size_t)row * D, lane);
    row_ln(r); row_affine(r, mod + 4096, mod + 3072, lane, true);
    row_store_bf16(r, HN + (size_t)row * D, lane);
    _Pragma("unroll") for (int j = 0; j < 4; ++j) *(float4*)&hs[wv][4 * lane + 256 * j] = r.v[j];
    __syncthreads();
    int e4; float g4;
    router_top4((const float*)hs[wv], w_router + (size_t)l * D * NE, b_router + l * NE, lane, e4, g4);
    if (lane < 4) {
        const int pos = atomicAdd(&CNT[l * NE + e4], 1);
        TE[row * 4 + lane] = e4; TG[row * 4 + lane] = g4; LIST[e4 * LCAP + pos] = row * 4 + lane;
    }
}
__global__ void __launch_bounds__(256) k_final(const float* __restrict__ X1, const bf16_t* __restrict__ YP, const float* __restrict__ MOD, const float* __restrict__ ln_g, const float* __restrict__ ln_b,
                                               const float* __restrict__ TG, int l, float* __restrict__ out) {
    const int lane = threadIdx.x & 63, row = blockIdx.x * 4 + (threadIdx.x >> 6), b = row / T;
    const float* mod = MOD + (size_t)(l * NB + b) * 6144;
    Row r = row_load(X1 + (size_t)row * D, lane);
    Row y;
    _Pragma("unroll") for (int j = 0; j < 4; ++j) y.v[j] = make_float4(0.f, 0.f, 0.f, 0.f);
#pragma unroll
    for (int k = 0; k < 4; ++k) {
        const float g = TG[row * 4 + k];
        const Row yk = row_load_bf16(YP + (size_t)(row * 4 + k) * D, lane);
        _Pragma("unroll") for (int j = 0; j < 4; ++j) { y.v[j].x += g * yk.v[j].x; y.v[j].y += g * yk.v[j].y; y.v[j].z += g * yk.v[j].z; y.v[j].w += g * yk.v[j].w; }
    }
    row_resid(r, y, mod + 5120, lane);
    row_ln(r); row_affine(r, ln_g + (l * 2 + 1) * D, ln_b + (l * 2 + 1) * D, lane, false);
    row_store_f32(r, out + (size_t)row * D, lane);
}

namespace pg8 {
#define PG8_LAS __attribute__((address_space(3)))
typedef short bf16x8 __attribute__((ext_vector_type(8)));
typedef float f32x4 __attribute__((ext_vector_type(4)));
typedef float f32x2 __attribute__((ext_vector_type(2)));
typedef unsigned u32x4 __attribute__((ext_vector_type(4)));
typedef unsigned u32x2 __attribute__((ext_vector_type(2)));
constexpr int BM = 256, BK = 64, HALF = 128, HTB = HALF * BK * 2  , STAGE_BYTES = 8 * HTB, NXCD = 8, WGM = 8;

__host__ __device__ __forceinline__ int lds_byte(int r, int c) { const int st = (r >> 4) * 2 + (c >> 5), rr = r & 15, cc = c & 31, ob = rr * 64 + cc * 2; return st * 1024 + (ob ^ (((ob >> 9) & 1) << 5)); }
__host__ __device__ __forceinline__ void stage_rc(int b, int& R, int& C) { const int st = b / 1024, sb = b % 1024, swz = sb ^ (((sb >> 9) & 1) << 5); R = (st >> 1) * 16 + swz / 64; C = (st & 1) * 32 + (swz % 64) / 2; }
__host__ __device__ __forceinline__ int perm32(int rho) { const int n = rho >> 4, i = rho & 15; return 8 * (i >> 2) + 4 * n + (i & 3); }

struct Unit { const char* a; const char* b; const int* rows; int pm, pn, e, nrows, shift, pad; };

struct StaticOrder {
    const char* A; const char* Bt; int nM, nN, nwg, G, c, K;
    DI void init(const bf16_t* A_, const bf16_t* Bt_, int M_, int N_, int K_, int G_, int c_) { A = (const char*)A_; Bt = (const char*)Bt_; nM = M_ / BM; nN = N_ / BM; nwg = nM * nN; G = G_; c = c_; K = K_; }
    DI bool next(int i, Unit& u) const {
        const long L = (long)i * G + c; if (L >= nwg) return false;
        int wgid = (int)L; { const int q = nwg / NXCD, r = nwg % NXCD, xcd = wgid % NXCD, off = wgid / NXCD; wgid = (xcd < r ? xcd * (q + 1) : r * (q + 1) + (xcd - r) * q) + off; }
        const int nig = WGM * nN, gid = wgid / nig, fm = gid * WGM, gsz = (nM - fm) < WGM ? (nM - fm) : WGM;
        u.pm = fm + ((wgid % nig) % gsz); u.pn = (wgid % nig) / gsz;
        u.a = A + (size_t)u.pm * BM * K * 2; u.b = Bt + (size_t)u.pn * BM * K * 2; u.rows = nullptr; u.e = 0; u.nrows = BM; u.shift = 0; u.pad = 0;
        return true;
    }
};
struct GroupedOrder {
    const char* A; const char* Bt; const int* cnt; const int* list; int nN, G, c, K, shift, total; size_t estride;
    DI void init(const bf16_t* A_, const bf16_t* Bt_, const int* cnt_, const int* list_, int N_, int K_, int shift_, int G_, int c_) {
        A = (const char*)A_; Bt = (const char*)Bt_; cnt = cnt_; list = list_; nN = N_ / BM; G = G_; c = c_; K = K_; shift = shift_; estride = (size_t)N_ * K_ * 2;
        int t = 0; for (int e = 0; e < NE; ++e) t += ((__builtin_amdgcn_readfirstlane(cnt[e]) + BM - 1) / BM) * nN; total = t;
    }
    DI bool next(int i, Unit& u) const {
        const long L = (long)i * G + c; if (L >= total) return false;
        int id = (int)L; { const int q = total / NXCD, r = total % NXCD, xcd = id % NXCD, off = id / NXCD; id = (xcd < r ? xcd * (q + 1) : r * (q + 1) + (xcd - r) * q) + off; }
        int e = 0, acc = 0;
        for (; e < NE; ++e) { const int te = ((__builtin_amdgcn_readfirstlane(cnt[e]) + BM - 1) / BM) * nN; if (id < acc + te) break; acc += te; }
        if (e >= NE) return false;
        const int rel = id - acc, mt = rel / nN, nt = rel % nN;
        u.pm = mt; u.pn = nt; u.e = e; u.a = A; u.b = Bt + (size_t)e * estride + (size_t)nt * BM * K * 2; u.rows = list + (size_t)e * LCAP + mt * BM;
        const int left = __builtin_amdgcn_readfirstlane(cnt[e]) - mt * BM; u.nrows = left < BM ? left : BM; u.shift = shift; u.pad = 0;
        return true;
    }
};

DI unsigned cvt_pk_bf16(float lo, float hi) { unsigned r; asm volatile("v_cvt_pk_bf16_f32 %0, %1, %2" : "=v"(r) : "v"(lo), "v"(hi)); return r; }

struct EpiBf16 {
    static constexpr bool PERM = true;
    bf16_t* O; int ldc;
    DI void operator()(const f32x4 (&acc)[2][2][4][2], const Unit& u, int wr, int wc, int fr, int fq) const {
        const int row0 = u.pm * BM + wr * 64 + fr, col0 = u.pn * BM + wc * 32 + 8 * fq;
#pragma unroll
        for (int ai = 0; ai < 2; ++ai)
#pragma unroll
            for (int m = 0; m < 4; ++m) { bf16_t* rowp = O + (size_t)(row0 + ai * HALF + m * 16) * ldc + col0;
#pragma unroll
                for (int bj = 0; bj < 2; ++bj) { const f32x4 v0 = acc[ai][bj][m][0], v1 = acc[ai][bj][m][1];
                    u32x4 w; w.x = cvt_pk_bf16(v0[0], v0[1]); w.y = cvt_pk_bf16(v0[2], v0[3]); w.z = cvt_pk_bf16(v1[0], v1[1]); w.w = cvt_pk_bf16(v1[2], v1[3]);
                    *(u32x4*)(rowp + bj * HALF) = w; } }
    }
};
DI float swiglu1(float glu, float lin) {
    glu = fminf(glu, 7.0f); lin = fminf(fmaxf(lin, -7.0f), 7.0f);
    const float s = __builtin_amdgcn_rcpf(1.0f + __builtin_amdgcn_exp2f(-1.702f * LOG2E * glu));
    return glu * s * (lin + 1.0f);
}
struct EpiSwiglu {
    static constexpr bool PERM = true;
    bf16_t* G; const float* b1;
    DI void operator()(const f32x4 (&acc)[2][2][4][2], const Unit& u, int wr, int wc, int fr, int fq) const {
        const int col0 = u.pn * BM + wc * 32 + 8 * fq; const float* bias = b1 + (size_t)u.e * 2048 + col0;
        f32x4 bv[2][2];
#pragma unroll
        for (int bj = 0; bj < 2; ++bj)
#pragma unroll
            for (int n = 0; n < 2; ++n) bv[bj][n] = *(const f32x4*)(bias + bj * HALF + 4 * n);
#pragma unroll
        for (int ai = 0; ai < 2; ++ai)
#pragma unroll
            for (int m = 0; m < 4; ++m) { const int rt = ai * HALF + wr * 64 + m * 16 + fr;
                if (rt < u.nrows) { const int slot = u.rows[rt]; bf16_t* rowp = G + (size_t)slot * FF + (col0 >> 1);
#pragma unroll
                    for (int bj = 0; bj < 2; ++bj) { const f32x4 v0 = acc[ai][bj][m][0] + bv[bj][0], v1 = acc[ai][bj][m][1] + bv[bj][1];
                        u32x2 w; w.x = cvt_pk_bf16(swiglu1(v0[0], v0[1]), swiglu1(v0[2], v0[3])); w.y = cvt_pk_bf16(swiglu1(v1[0], v1[1]), swiglu1(v1[2], v1[3]));
                        *(u32x2*)(rowp + bj * (HALF / 2)) = w; } } }
    }
};
struct EpiBiasScatter {
    static constexpr bool PERM = true;
    bf16_t* O; const float* b2;
    DI void operator()(const f32x4 (&acc)[2][2][4][2], const Unit& u, int wr, int wc, int fr, int fq) const {
        const int col0 = u.pn * BM + wc * 32 + 8 * fq; const float* bias = b2 + (size_t)u.e * 1024 + col0;
        f32x4 bv[2][2];
#pragma unroll
        for (int bj = 0; bj < 2; ++bj)
#pragma unroll
            for (int n = 0; n < 2; ++n) bv[bj][n] = *(const f32x4*)(bias + bj * HALF + 4 * n);
#pragma unroll
        for (int ai = 0; ai < 2; ++ai)
#pragma unroll
            for (int m = 0; m < 4; ++m) { const int rt = ai * HALF + wr * 64 + m * 16 + fr;
                if (rt < u.nrows) { const int slot = u.rows[rt]; bf16_t* rowp = O + (size_t)slot * D + col0;
#pragma unroll
                    for (int bj = 0; bj < 2; ++bj) { const f32x4 v0 = acc[ai][bj][m][0] + bv[bj][0], v1 = acc[ai][bj][m][1] + bv[bj][1];
                        u32x4 w; w.x = cvt_pk_bf16(v0[0], v0[1]); w.y = cvt_pk_bf16(v0[2], v0[3]); w.z = cvt_pk_bf16(v1[0], v1[1]); w.w = cvt_pk_bf16(v1[2], v1[3]);
                        *(u32x4*)(rowp + bj * HALF) = w; } } }
    }
};

DI void unit_rows(const Unit& u, int tid, unsigned (&raw)[2][2]) {
#pragma unroll
    for (int h = 0; h < 2; ++h)
#pragma unroll
        for (int i = 0; i < 2; ++i) { int R, C; stage_rc(tid * 16 + i * 8192, R, C); const int rr = h * HALF + R; int idx = rr;
            if (u.rows) idx = rr < u.nrows ? u.rows[rr] : 0;
            raw[h][i] = (unsigned)idx; }
}
DI void unit_offA(const Unit& u, int tid, int K, unsigned (&o)[2][2]) {
#pragma unroll
    for (int h = 0; h < 2; ++h)
#pragma unroll
        for (int i = 0; i < 2; ++i) { int R, C; stage_rc(tid * 16 + i * 8192, R, C); o[h][i] = ((o[h][i] >> u.shift) * (unsigned)K + (unsigned)C) * 2u; }
}

template <class Epi, class Sched>
DI void gemm_phase(PG8_LAS unsigned char* lds, int K, const Sched& S, const Epi& E) {
    const int tid = opaque_tid(), wid = __builtin_amdgcn_readfirstlane(tid >> 6), lane = tid & 63, wr = wid >> 2, wc = wid & 3, fr = lane & 15, fq = lane >> 4;
    const int nt = K / BK;
    unsigned voffB[2];
#pragma unroll
    for (int i = 0; i < 2; ++i) { int R, C; stage_rc(tid * 16 + i * 8192, R, C); const int Rb = Epi::PERM ? ((R & ~31) + perm32(R & 31)) : R;
        voffB[i] = (unsigned)(Rb * K + C) * 2u; }
    const size_t kstep = (size_t)(BK * 2);
    const size_t hstep = (size_t)HALF * K * 2;
    const unsigned ldsw = (unsigned)wid * 1024u;
    const int aoff = lds_byte(wr * 64 + fr, fq * 8), boff = lds_byte(wc * 32 + fr, fq * 8);
#define PG8_SA(b, h) (((b) * 2 + (h)) * HTB)
#define PG8_SB(b, h) ((4 + (b) * 2 + (h)) * HTB)
#define PG8_STAGE(bufoff, gbase, voff) do { _Pragma("unroll") for (int _i = 0; _i < 2; ++_i) \
        __builtin_amdgcn_global_load_lds((const unsigned*)((const char*)(gbase) + (voff)[_i]), (PG8_LAS unsigned*)(lds + (bufoff) + ldsw + _i * 8192), 16, 0, 0); } while (0)
#define PG8_LDA(dst, b, h) do { _Pragma("unroll") for (int m = 0; m < 4; ++m) _Pragma("unroll") for (int k = 0; k < 2; ++k) dst[m][k] = *(const PG8_LAS bf16x8*)(lds + PG8_SA(b, h) + aoff + m * 2048 + k * 1024); } while (0)
#define PG8_LDB(dst, b, h) do { _Pragma("unroll") for (int n = 0; n < 2; ++n) _Pragma("unroll") for (int k = 0; k < 2; ++k) dst[n][k] = *(const PG8_LAS bf16x8*)(lds + PG8_SB(b, h) + boff + n * 2048 + k * 1024); } while (0)
#define PG8_MMA(ai, bj, At, Bt) do { __builtin_amdgcn_s_setprio(1); _Pragma("unroll") for (int m = 0; m < 4; ++m) _Pragma("unroll") for (int n = 0; n < 2; ++n) _Pragma("unroll") for (int k = 0; k < 2; ++k) \
        acc[ai][bj][m][n] = __builtin_amdgcn_mfma_f32_16x16x32_bf16(Bt[n][k], At[m][k], acc[ai][bj][m][n], 0, 0, 0); __builtin_amdgcn_s_setprio(0); } while (0)
#define PG8_WAIT_V(n) asm volatile("s_waitcnt vmcnt(" #n ")" ::: "memory")
#define PG8_WAIT_L(n) asm volatile("s_waitcnt lgkmcnt(" #n ")" ::: "memory")
#define PG8_BAR __builtin_amdgcn_s_barrier()
#define PG8_SCHED __builtin_amdgcn_sched_barrier(0)
    Unit cur, nxt; int ui = 0;
    if (!S.next(0, cur)) return;
    unsigned offA[2][2], offN[2][2];
    unit_rows(cur, tid, offA); unit_offA(cur, tid, K, offA);
    f32x4 acc[2][2][4][2];
#pragma unroll
    for (int a = 0; a < 2; ++a)
#pragma unroll
        for (int b = 0; b < 2; ++b)
#pragma unroll
            for (int m = 0; m < 4; ++m)
#pragma unroll
                for (int n = 0; n < 2; ++n) acc[a][b][m][n] = (f32x4){0.f, 0.f, 0.f, 0.f};
    bf16x8 At[4][2], B0[2][2], B1[2][2];
    const char* cA = cur.a; const char* cB = cur.b;
    PG8_STAGE(PG8_SB(0, 0), cB, voffB); PG8_STAGE(PG8_SB(0, 1), cB + hstep, voffB); PG8_STAGE(PG8_SA(0, 0), cA, offA[0]); PG8_STAGE(PG8_SA(0, 1), cA, offA[1]);
    if (wr == 1) PG8_BAR;
    PG8_WAIT_V(2); PG8_BAR;
    PG8_STAGE(PG8_SB(1, 0), cB + kstep, voffB); PG8_STAGE(PG8_SA(1, 0), cA + kstep, offA[0]); PG8_STAGE(PG8_SB(1, 1), cB + hstep + kstep, voffB);
    PG8_WAIT_V(6); PG8_BAR;
    for (;;) {
        const bool has_next = S.next(ui + 1, nxt);
        if (has_next) unit_rows(nxt, tid, offN);
        else {
#pragma unroll
            for (int h = 0; h < 2; ++h)
#pragma unroll
                for (int i = 0; i < 2; ++i) offN[h][i] = offA[h][i]; }
        const char* nA = has_next ? nxt.a : cA; const char* nB = has_next ? nxt.b : cB;
        for (int t = 0; t < nt; t += 2) {
            const bool last = (t == nt - 2);
            const char* a1 = cA + (size_t)(t + 1) * kstep;
            const char* a2 = last ? nA : cA + (size_t)(t + 2) * kstep; const char* b2 = last ? nB : cB + (size_t)(t + 2) * kstep;
            const char* a3 = a2 + kstep; const char* b3 = b2 + kstep;
            PG8_LDB(B0, 0, 0); PG8_LDB(B1, 0, 1); PG8_SCHED; PG8_LDA(At, 0, 0); PG8_STAGE(PG8_SA(1, 1), a1, offA[1]);
            if (last) {
                if (has_next) { asm volatile("" : "+v"(offN[0][0]), "+v"(offN[0][1]), "+v"(offN[1][0]), "+v"(offN[1][1])); unit_offA(nxt, tid, K, offN); }
#pragma unroll
                for (int h = 0; h < 2; ++h)
#pragma unroll
                    for (int i = 0; i < 2; ++i) offA[h][i] = offN[h][i];
            }
            PG8_WAIT_V(8); PG8_WAIT_L(0); PG8_BAR; PG8_MMA(0, 0, At, B0); PG8_MMA(0, 1, At, B1); PG8_BAR; PG8_SCHED;
            PG8_LDA(At, 0, 1); PG8_STAGE(PG8_SB(0, 0), b2, voffB); PG8_STAGE(PG8_SB(0, 1), b2 + hstep, voffB); PG8_STAGE(PG8_SA(0, 0), a2, offA[0]);
            PG8_WAIT_V(8); PG8_WAIT_L(0); PG8_BAR; PG8_MMA(1, 0, At, B0); PG8_MMA(1, 1, At, B1); PG8_BAR; PG8_SCHED;
            PG8_LDB(B0, 1, 0); PG8_LDB(B1, 1, 1); PG8_SCHED; PG8_LDA(At, 1, 0); PG8_STAGE(PG8_SA(0, 1), a2, offA[1]);
            PG8_WAIT_V(8); PG8_WAIT_L(0); PG8_BAR; PG8_MMA(0, 0, At, B0); PG8_MMA(0, 1, At, B1); PG8_BAR; PG8_SCHED;
            PG8_LDA(At, 1, 1); PG8_STAGE(PG8_SB(1, 0), b3, voffB); PG8_STAGE(PG8_SB(1, 1), b3 + hstep, voffB); PG8_STAGE(PG8_SA(1, 0), a3, offA[0]);
            PG8_WAIT_V(8); PG8_WAIT_L(0); PG8_BAR; PG8_MMA(1, 0, At, B0); PG8_MMA(1, 1, At, B1); PG8_BAR; PG8_SCHED;
        }
        if (wr == 0) PG8_BAR;
        E(acc, cur, wr, wc, fr, fq);
        if (!has_next) break;
#pragma unroll
        for (int a = 0; a < 2; ++a)
#pragma unroll
            for (int b = 0; b < 2; ++b)
#pragma unroll
                for (int m = 0; m < 4; ++m)
#pragma unroll
                    for (int n = 0; n < 2; ++n) acc[a][b][m][n] = (f32x4){0.f, 0.f, 0.f, 0.f};
        cur = nxt; cA = nA; cB = nB; ++ui;
        if (wr == 1) PG8_BAR;
    }
    PG8_WAIT_V(0);
    PG8_BAR;
#undef PG8_SA
#undef PG8_SB
#undef PG8_STAGE
#undef PG8_LDA
#undef PG8_LDB
#undef PG8_MMA
#undef PG8_WAIT_V
#undef PG8_WAIT_L
#undef PG8_BAR
#undef PG8_SCHED
}
}

namespace att {
#define LAS __attribute__((address_space(3)))
typedef short bf16x8 __attribute__((ext_vector_type(8)));
typedef short s16x4 __attribute__((ext_vector_type(4)));
typedef float f32x16 __attribute__((ext_vector_type(16)));
typedef float f32x2_t __attribute__((ext_vector_type(2)));
typedef __bf16 bf16x2_t __attribute__((ext_vector_type(2)));
typedef unsigned u32x4 __attribute__((ext_vector_type(4)));
typedef unsigned u32x2 __attribute__((ext_vector_type(2)));

DI int pi32(int r) { return (r & 0x13) | ((r & 4) << 1) | ((r & 8) >> 1); }
DI unsigned koff(int row, int c) { return (unsigned)(row * 128 + (((c ^ (row >> 1)) & 7) << 4)); }
DI unsigned voff(int key, int ch) { return (unsigned)(1024 * (key >> 3) + 512 * (ch >> 2) + 64 * (key & 7) + 16 * ((ch & 3) ^ ((key >> 2) & 3))); }
DI unsigned cvtpk(float lo, float hi) { f32x2_t v = {lo, hi}; bf16x2_t b = __builtin_convertvector(v, bf16x2_t); return __builtin_bit_cast(unsigned, b); }
DI float ex2(float x) { return __builtin_amdgcn_exp2f(x); }
DI float lg2(float x) { return __builtin_amdgcn_logf(x); }
DI float xhalf(float v) { const auto rr = __builtin_amdgcn_permlane32_swap(__float_as_uint(v), __float_as_uint(v), false, false); return __uint_as_float(rr[0]) + __uint_as_float(rr[1]) - v; }
DI float hsum(float v) { const auto rr = __builtin_amdgcn_permlane32_swap(__float_as_uint(v), __float_as_uint(v), false, false); return __uint_as_float(rr[0]) + __uint_as_float(rr[1]); }
DI float hmax(float v) { const auto rr = __builtin_amdgcn_permlane32_swap(__float_as_uint(v), __float_as_uint(v), false, false); return fmaxf(__uint_as_float(rr[0]), __uint_as_float(rr[1])); }
DI float hother(float v) { const auto rr = __builtin_amdgcn_permlane32_swap(__float_as_uint(v), __float_as_uint(v), false, false); return (__builtin_amdgcn_mbcnt_hi(~0u, __builtin_amdgcn_mbcnt_lo(~0u, 0u)) & 32) ? __uint_as_float(rr[0]) : __uint_as_float(rr[1]); }

template <int D0LO, int D0HI> DI void qk(f32x16& p0, f32x16& p1, const LAS char* kimg, const bf16x8 (&q)[4], int prow, int hh) {
#pragma unroll
    for (int d0 = D0LO; d0 < D0HI; ++d0) {
        const unsigned o = koff(prow, 2 * d0 + hh);
        const bf16x8 a0 = *(const LAS bf16x8*)(kimg + o), a1 = *(const LAS bf16x8*)(kimg + 4096 + o);
        p0 = __builtin_amdgcn_mfma_f32_32x32x16_bf16(a0, q[d0], p0, 0, 0, 0);
        p1 = __builtin_amdgcn_mfma_f32_32x32x16_bf16(a1, q[d0], p1, 0, 0, 0);
    }
}
DI bf16x8 pack8(const f32x16& p, int s) {
    u32x4 w;
    if (s == 0) { w.x = cvtpk(p[0], p[1]); w.y = cvtpk(p[2], p[3]); w.z = cvtpk(p[4], p[5]); w.w = cvtpk(p[6], p[7]); }
    else { w.x = cvtpk(p[8], p[9]); w.y = cvtpk(p[10], p[11]); w.z = cvtpk(p[12], p[13]); w.w = cvtpk(p[14], p[15]); }
    return __builtin_bit_cast(bf16x8, w);
}
typedef short v4i16_t __attribute__((ext_vector_type(4)));
DI s16x4 vtr(const LAS char* p) { return __builtin_bit_cast(s16x4, __builtin_amdgcn_ds_read_tr16_b64_v4i16((LAS v4i16_t*)p)); }
DI void pv(f32x16 (&o)[2], const LAS char* vimg, const f32x16& p0, const f32x16& p1, int lane) {
    const int g = lane >> 4, i16 = lane & 15, qd = i16 >> 2, pp = i16 & 3, hh = g >> 1;
    const LAS char* vb0 = vimg + voff(8 * hh + qd, 2 * (g & 1) + (pp >> 1)) + 8 * (pp & 1);
    const LAS char* vb1 = vimg + voff(8 * hh + 4 + qd, 2 * (g & 1) + (pp >> 1)) + 8 * (pp & 1);
    bf16x8 pf[4];
    pf[0] = pack8(p0, 0); pf[1] = pack8(p0, 1); pf[2] = pack8(p1, 0); pf[3] = pack8(p1, 1);
#pragma unroll
    for (int c = 0; c < 2; ++c)
#pragma unroll
        for (int s = 0; s < 4; ++s) {
            const s16x4 lo = vtr(vb0 + 2048 * s + 512 * c);
            const s16x4 hi = vtr(vb1 + 2048 * s + 512 * c);
            const bf16x8 vf = __builtin_shufflevector(lo, hi, 0, 1, 2, 3, 4, 5, 6, 7);
            o[c] = __builtin_amdgcn_mfma_f32_32x32x16_bf16(vf, pf[s], o[c], 0, 0, 0);
        }
}
DI void softmax_step(f32x16& p0, f32x16& p1, float& m, float& l, f32x16 (&o)[2]) {
    float mx = fmaxf(p0[0], p1[0]);
#pragma unroll
    for (int i = 1; i < 16; ++i) mx = fmaxf(mx, fmaxf(p0[i], p1[i]));
    mx = hmax(mx);
    const float mn = fmaxf(m, mx), al = ex2(m - mn);
    float s = 0.f;
#pragma unroll
    for (int i = 0; i < 16; ++i) { p0[i] = ex2(p0[i] - mn); p1[i] = ex2(p1[i] - mn); s += p0[i] + p1[i]; }
    l = l * al + s; m = mn;
#pragma unroll
    for (int i = 0; i < 16; ++i) { o[0][i] *= al; o[1][i] *= al; }
}
DI void store_ot(bf16_t* orow, const f32x16 (&o)[2], float sc, int hh) {
#pragma unroll
    for (int c = 0; c < 2; ++c)
#pragma unroll
        for (int g = 0; g < 4; ++g) { u32x2 w; w.x = cvtpk(o[c][4 * g] * sc, o[c][4 * g + 1] * sc); w.y = cvtpk(o[c][4 * g + 2] * sc, o[c][4 * g + 3] * sc);
            *(u32x2*)(orow + 32 * c + 8 * g + 4 * hh) = w; }
}
DI void load_q(bf16x8 (&q)[4], const bf16_t* qrow, int hh) {
#pragma unroll
    for (int d0 = 0; d0 < 4; ++d0) q[d0] = *(const bf16x8*)(qrow + 16 * d0 + 8 * hh);
}

template <class RowFn> DI void stage_wave(LAS char* kimg, LAS char* vimg, int koffs, int voffs, const RowFn& rowptr, int lane) {
    u32x4 kr[8], vr[8];
    const int ch = lane & 7;
#pragma unroll
    for (int c = 0; c < 8; ++c) { const int row = (lane >> 3) + 8 * c; const bf16_t* p = rowptr(row);
        kr[c] = p ? *(const u32x4*)(p + koffs + 8 * ch) : (u32x4){0u, 0u, 0u, 0u};
        vr[c] = p ? *(const u32x4*)(p + voffs + 8 * ch) : (u32x4){0u, 0u, 0u, 0u}; }
#pragma unroll
    for (int c = 0; c < 8; ++c) { const int row = (lane >> 3) + 8 * c;
        *(LAS u32x4*)(kimg + koff(row, ch)) = kr[c];
        *(LAS u32x4*)(vimg + voff(row, ch)) = vr[c]; }
    asm volatile("s_waitcnt lgkmcnt(0)" ::: "memory");
}

DI void attnA_unit(LAS char* wlds, const bf16_t* P, bf16_t* MG, int b, int h, int qblk, int lane) {
    const int r = lane & 31, hh = lane >> 5, prow = pi32(r), t0 = 32 * qblk, t = t0 + r;
    const bf16_t* base = P + (size_t)b * T * PP;
    LAS char* kimg = wlds; LAS char* vimg = wlds + 8192;
    bf16x8 q[4]; load_q(q, base + (size_t)t * PP + QA + h * 64, hh);
    f32x16 o[2]; o[0] = (f32x16){}; o[1] = (f32x16){};
    float S2 = 0.f;
    const float C2 = 0.125f * LOG2E;
    for (int k = 0;; ++k) {
        const int kb = t0 + 32 - 64 * (k + 1);
        if (kb + 63 < 0) break;
        stage_wave(kimg, vimg, KA + h * 64, VA + h * 64, [&](int i) -> const bf16_t* { const int s = kb + i; return s >= 0 ? base + (size_t)s * PP : nullptr; }, lane);
        f32x16 p0 = (f32x16){}, p1 = (f32x16){};
        qk<0, 4>(p0, p1, kimg, q, prow, hh);
        f32x16 sp0, sp1;
#pragma unroll
        for (int i = 0; i < 16; ++i) {
            const int s0 = kb + 16 * (i >> 3) + 8 * hh + (i & 7), s1 = s0 + 32;
            const float z0 = p0[i] * C2, z1 = p1[i] * C2;
            const bool v0 = (s0 >= 0) && (s0 < t), v1 = (s1 >= 0) && (s1 < t);
            const float a0 = fmaxf(z0, 0.f) + lg2(1.f + ex2(-fabsf(z0))), a1 = fmaxf(z1, 0.f) + lg2(1.f + ex2(-fabsf(z1)));
            sp0[i] = v0 ? a0 : 0.f; sp1[i] = v1 ? a1 : 0.f;
            p0[i] = v0 ? z0 - a0 : -INFINITY; p1[i] = v1 ? z1 - a1 : -INFINITY;
        }
        float own[4], part[4];
#pragma unroll
        for (int u = 0; u < 2; ++u) {
            float a = 0.f, c = 0.f;
#pragma unroll
            for (int e = 0; e < 8; ++e) { a += sp0[8 * u + e]; c += sp1[8 * u + e]; }
            own[u] = a; own[2 + u] = c;
        }
#pragma unroll
        for (int v = 0; v < 4; ++v) part[v] = hother(own[v]);
        float above[4];
        above[3] = (hh == 0) ? part[3] : 0.f;
#pragma unroll
        for (int v = 2; v >= 0; --v) above[v] = above[v + 1] + own[v + 1] + ((hh == 0) ? part[v] : part[v + 1]);
#pragma unroll
        for (int u = 0; u < 2; ++u) {
            float e0 = S2 + above[u], e1 = S2 + above[2 + u];
#pragma unroll
            for (int e = 7; e >= 0; --e) {
                const float w0 = ex2(p0[8 * u + e] - e0), w1 = ex2(p1[8 * u + e] - e1);
                e0 += sp0[8 * u + e]; e1 += sp1[8 * u + e];
                p0[8 * u + e] = w0; p1[8 * u + e] = w1;
            }
        }
        S2 += (own[0] + own[1]) + (own[2] + own[3]) + (part[0] + part[1]) + (part[2] + part[3]);
        pv(o, vimg, p0, p1, lane);
        if (__all(S2 >= 151.0f)) break;
    }
    store_ot(MG + (size_t)(b * T + t) * D + 0 + h * 64, o, 1.0f, hh);
}

DI void attnB_unit(LAS char* wlds, LAS float* tab  , const bf16_t* P, const float* rel_bias, bf16_t* MG, int b, int h, int rho, int ub, int lane) {
    const int r = lane & 31, hh = lane >> 5, prow = pi32(r), t = 16 * (32 * ub + r) + rho;
    const bf16_t* base = P + (size_t)b * T * PP;
    LAS char* kimg = wlds; LAS char* vimg = wlds + 8192;
    for (int i = lane; i < 3 * 129; i += 64) { const int cfg = i / 129, m = i % 129, dil = cfg == 0 ? 1 : (cfg == 1 ? 4 : 16); tab[cfg * 132 + m] = rel_bias[rel_bucket(m * dil) * 12 + h] * LOG2E; }
    asm volatile("s_waitcnt lgkmcnt(0)" ::: "memory");
    bf16x8 q[4]; load_q(q, base + (size_t)t * PP + QB_ + h * 64, hh);
    f32x16 o[2]; o[0] = (f32x16){}; o[1] = (f32x16){};
    float m = -1e30f, l = 0.f;
    const float C2 = 0.125f * LOG2E;
#pragma unroll 1
    for (int cfg = 0; cfg < 3; ++cfg) {
        const int lg = 2 * cfg, dil = 1 << lg, rc = rho & (dil - 1);
        const int uq = (t - rc) >> lg, uq0 = (16 * 32 * ub + rho - rc) >> lg;
        const int span = (16 >> lg) * 31 + 129, ntile = (span + 63) >> 6;
        const LAS float* tb = tab + cfg * 132;
#pragma unroll 1
        for (int k = 0; k < ntile; ++k) {
            const int U = uq0 - 128 + 64 * k;
            stage_wave(kimg, vimg, KB_ + h * 64, VB_ + h * 64, [&](int i) -> const bf16_t* { const int u = U + i; const int s = (u << lg) + rc; return (u >= 0 && s < T) ? base + (size_t)s * PP : nullptr; }, lane);
            f32x16 p0 = (f32x16){}, p1 = (f32x16){};
            qk<0, 4>(p0, p1, kimg, q, prow, hh);
#pragma unroll
            for (int i = 0; i < 16; ++i) {
                const int u0 = U + 16 * (i >> 3) + 8 * hh + (i & 7), u1 = u0 + 32;
                const int m0 = uq - u0, m1 = uq - u1;
                const bool v0 = (u0 >= 0) && (m0 >= 0) && (m0 <= 128), v1 = (u1 >= 0) && (m1 >= 0) && (m1 <= 128);
                const float b0 = tb[v0 ? m0 : 0], b1 = tb[v1 ? m1 : 0];
                p0[i] = v0 ? p0[i] * C2 + b0 : -INFINITY; p1[i] = v1 ? p1[i] * C2 + b1 : -INFINITY;
            }
            softmax_step(p0, p1, m, l, o);
            pv(o, vimg, p0, p1, lane);
        }
    }
    l = hsum(l);
    store_ot(MG + (size_t)(b * T + t) * D + 256 + h * 64, o, 1.0f / l, hh);
}

template <int MODE> DI void dense_unit(LAS char* sh, const LAS float* btab, float bias_far2, const bf16_t* P, const unsigned* MASK, const float* diff_g_l, float lam, float lam_init, bf16_t* MG, int b, int h, int qb, int tid) {
    const int lane = tid & 63, wid = __builtin_amdgcn_readfirstlane(tid >> 6), r = lane & 31, hh = lane >> 5, prow = pi32(r);
    const int t0w = 256 * qb + 32 * wid, t = t0w + r;
    const bf16_t* base = P + (size_t)b * T * PP;
    constexpr int QO = MODE == 0 ? QC : QD, KO = MODE == 0 ? KC : KD, VO = MODE == 0 ? VC : VD;
    bf16x8 q[4]; load_q(q, base + (size_t)t * PP + QO + h * 64, hh);
    f32x16 o1[2], o2[2]; o1[0] = (f32x16){}; o1[1] = (f32x16){}; o2[0] = (f32x16){}; o2[1] = (f32x16){};
    float m1 = -1e30f, l1 = 0.f, m2 = -1e30f, l2 = 0.f;
    const float C2 = (MODE == 0 ? 0.125f : 0.17677669529663687f) * LOG2E;
    const int ntile = 4 * qb + 4, my_last = (t0w + 31) >> 6;
    const unsigned long long* mrow = (const unsigned long long*)(MASK + (size_t)(b * T + t) * 128);
    const int srow = tid >> 3, sch = tid & 7;
    const bf16_t* sp = base + (size_t)srow * PP + 8 * sch;
    u32x4 kr = *(const u32x4*)(sp + KO + h * 64), vr = *(const u32x4*)(sp + VO + h * 64);
    *(LAS u32x4*)(sh + koff(srow, sch)) = kr; *(LAS u32x4*)(sh + 16384 + voff(srow, sch)) = vr;
    asm volatile("s_waitcnt lgkmcnt(0)" ::: "memory"); __builtin_amdgcn_s_barrier(); asm volatile("" ::: "memory");
#pragma unroll 1
    for (int j = 0; j < ntile; ++j) {
        const LAS char* kimg = sh + (j & 1) * 8192; const LAS char* vimg = sh + 16384 + (j & 1) * 8192;
        if (j + 1 < ntile) { const bf16_t* sn = sp + (size_t)(64 * (j + 1)) * PP; kr = *(const u32x4*)(sn + KO + h * 64); vr = *(const u32x4*)(sn + VO + h * 64); }
        if (j <= my_last) {
            unsigned long long mbits = 0ull;
            if (MODE == 0) mbits = mrow[j] >> (8 * hh);
            const bool nearb = 64 * j + 176 > t0w;
            const LAS float* bt = btab + (96 - 55 + t - 64 * j - 8 * hh);
            f32x16 p0, p1;
            const float binit = nearb ? 0.f : bias_far2 / C2;
#pragma unroll
            for (int i = 0; i < 16; ++i) { p0[i] = binit; p1[i] = binit; }
            if (MODE == 0) qk<0, 4>(p0, p1, kimg, q, prow, hh); else qk<0, 2>(p0, p1, kimg, q, prow, hh);
            if (nearb) {
#pragma unroll
                for (int i = 0; i < 16; ++i) { const int ci = 16 * (i >> 3) + (i & 7);
                    p0[i] = p0[i] * C2 + bt[55 - ci]; p1[i] = p1[i] * C2 + bt[55 - ci - 32]; }
            } else {
#pragma unroll
                for (int i = 0; i < 16; ++i) { p0[i] *= C2; p1[i] *= C2; }
            }
            if (MODE == 0) {
#pragma unroll
                for (int i = 0; i < 16; ++i) { const int kk = 16 * (i >> 3) + (i & 7);
                    if (!((mbits >> kk) & 1ull)) p0[i] = -INFINITY;
                    if (!((mbits >> (kk + 32)) & 1ull)) p1[i] = -INFINITY; }
            }
            softmax_step(p0, p1, m1, l1, o1);
            pv(o1, vimg, p0, p1, lane);
            if (MODE == 1) {
#pragma unroll
                for (int i = 0; i < 16; ++i) { p0[i] = binit; p1[i] = binit; }
                qk<2, 4>(p0, p1, kimg, q, prow, hh);
                if (nearb) {
#pragma unroll
                    for (int i = 0; i < 16; ++i) { const int ci = 16 * (i >> 3) + (i & 7);
                        p0[i] = p0[i] * C2 + bt[55 - ci]; p1[i] = p1[i] * C2 + bt[55 - ci - 32]; }
                } else {
#pragma unroll
                    for (int i = 0; i < 16; ++i) { p0[i] *= C2; p1[i] *= C2; }
                }
                softmax_step(p0, p1, m2, l2, o2);
                pv(o2, vimg, p0, p1, lane);
            }
        }
        if (j + 1 < ntile) { *(LAS u32x4*)(sh + ((j + 1) & 1) * 8192 + koff(srow, sch)) = kr; *(LAS u32x4*)(sh + 16384 + ((j + 1) & 1) * 8192 + voff(srow, sch)) = vr; }
        asm volatile("s_waitcnt lgkmcnt(0)" ::: "memory"); __builtin_amdgcn_s_barrier(); asm volatile("" ::: "memory");
    }
    bf16_t* orow = MG + (size_t)(b * T + t) * D + (MODE == 0 ? 512 : 768) + h * 64;
    l1 = hsum(l1);
    if (MODE == 0) { store_ot(orow, o1, 1.0f / l1, hh); }
    else {
        l2 = hsum(l2);
        const float i1 = 1.0f / l1, i2 = lam / l2;
        float ss = 0.f;
#pragma unroll
        for (int c = 0; c < 2; ++c)
#pragma unroll
            for (int i = 0; i < 16; ++i) { const float v = o1[c][i] * i1 - o2[c][i] * i2; o1[c][i] = v; ss += v * v; }
        ss = hsum(ss);
        const float rs = 1.0f / sqrtf(ss * (1.f / 64.f) + LN_EPS) * (1.f - lam_init);
#pragma unroll
        for (int c = 0; c < 2; ++c)
#pragma unroll
            for (int g = 0; g < 4; ++g) { const float4 gv = *(const float4*)(diff_g_l + 32 * c + 8 * g + 4 * hh);
                o1[c][4 * g] *= gv.x; o1[c][4 * g + 1] *= gv.y; o1[c][4 * g + 2] *= gv.z; o1[c][4 * g + 3] *= gv.w; }
        store_ot(orow, o1, rs, hh);
    }
}

DI void idx_unit(LAS char* sh, const bf16_t* P, float* SC, int b, int q64, int tid) {
    const int lane = tid & 63, wid = __builtin_amdgcn_readfirstlane(tid >> 6), r = lane & 31, hh = lane >> 5;
    const bf16_t* base = P + (size_t)b * T * PP;
    const int tq0 = 64 * q64 + 8 * wid;
    bf16x8 qa[4][4]; float wv[4][16];
#pragma unroll
    for (int rb = 0; rb < 4; ++rb) { const bf16_t* qrow = base + (size_t)(tq0 + 2 * rb + (r >> 4)) * PP + QX + (r & 15) * 64;
#pragma unroll
        for (int d0 = 0; d0 < 4; ++d0) qa[rb][d0] = *(const bf16x8*)(qrow + 16 * d0 + 8 * hh);
#pragma unroll
        for (int i = 0; i < 16; ++i) { const int hd = (i & 3) + 8 * ((i >> 2) & 1) + 4 * hh; wv[rb][i] = bf2f(base[(size_t)(tq0 + 2 * rb + (i >> 3)) * PP + WX + hd]) * (0.25f * 0.125f); }
    }
    const int ntile = q64 + 1;
    const int srow = tid >> 3, sch = tid & 7;
    const bf16_t* sp = base + (size_t)srow * PP + KX + 8 * sch;
    u32x4 kr = *(const u32x4*)sp;
    *(LAS u32x4*)(sh + koff(srow, sch)) = kr;
    asm volatile("s_waitcnt lgkmcnt(0)" ::: "memory"); __builtin_amdgcn_s_barrier(); asm volatile("" ::: "memory");
#pragma unroll 1
    for (int j = 0; j < ntile; ++j) {
        const LAS char* kimg = sh + (j & 1) * 8192;
        if (j + 1 < ntile) kr = *(const u32x4*)(sp + (size_t)(64 * (j + 1)) * PP);
#pragma unroll
        for (int kb = 0; kb < 2; ++kb) {
            bf16x8 kf[4];
#pragma unroll
            for (int d0 = 0; d0 < 4; ++d0) kf[d0] = *(const LAS bf16x8*)(kimg + koff(32 * kb + r, 2 * d0 + hh));
#pragma unroll
            for (int rb = 0; rb < 4; ++rb) {
                f32x16 acc = (f32x16){};
#pragma unroll
                for (int d0 = 0; d0 < 4; ++d0) acc = __builtin_amdgcn_mfma_f32_32x32x16_bf16(qa[rb][d0], kf[d0], acc, 0, 0, 0);
                float s0 = 0.f, s1 = 0.f;
#pragma unroll
                for (int i = 0; i < 8; ++i) { s0 += wv[rb][i] * fmaxf(acc[i], 0.f); s1 += wv[rb][8 + i] * fmaxf(acc[8 + i], 0.f); }
                const float give = hh ? s0 : s1, keep = hh ? s1 : s0;
                const float tot = keep + hother(give);
                SC[((size_t)b * T + tq0 + 2 * rb + hh) * T + 64 * j + 32 * kb + r] = tot;
            }
        }
        if (j + 1 < ntile) *(LAS u32x4*)(sh + ((j + 1) & 1) * 8192 + koff(srow, sch)) = kr;
        asm volatile("s_waitcnt lgkmcnt(0)" ::: "memory"); __builtin_amdgcn_s_barrier(); asm volatile("" ::: "memory");
    }
}
#undef LAS
}

constexpr int NWAVES = 8, NTHREADS = 512;
constexpr int RING_BYTES = 131072, TAB_OFF = 131072, BTAB_OFF = TAB_OFF, MISC_OFF = 147456 - 256, LDS_BYTES = 147456;
static_assert(TAB_OFF + 8 * 1584 <= MISC_OFF, "LDS map");
#define GAS __attribute__((address_space(1)))
#define LAS __attribute__((address_space(3)))

#define XB_TMO      128
#define XB_XCNT(j)  (256  + 64 * (j))
#define XB_XSUB(j)  (1280 + 64 * (j))
#define XB_XGEN(j)  (2304 + 64 * (j))
#define XB_TOP      3328
#define XB_TOPGEN   3392
#define XCD_BAR_WORDS 3456
#define XB_SPIN_CAP (1u << 22)
DI unsigned xb_ld(unsigned* p)              { return __hip_atomic_load(p, __ATOMIC_RELAXED, __HIP_MEMORY_SCOPE_AGENT); }
DI unsigned xb_add(unsigned* p, unsigned v) { return __hip_atomic_fetch_add(p, v, __ATOMIC_RELAXED, __HIP_MEMORY_SCOPE_AGENT); }
DI unsigned xb_xcc_id() { return (unsigned)__builtin_amdgcn_s_getreg((3 << 11) | 20) & 0xFu; }
#define XB_SPIN(cond, bar) do { unsigned _sp = 0; while (cond) { __builtin_amdgcn_s_sleep(1); \
    if ((++_sp & 255u) == 0u) { if (xb_ld(&(bar)[XB_TMO])) break; if (_sp > XB_SPIN_CAP) { atomicAdd(&(bar)[XB_TMO], 1u); break; } } } } while (0)
struct XcdBarrier { unsigned* bar; unsigned x; volatile LAS unsigned* st; };
DI XcdBarrier xcd_barrier_post(unsigned* bar, volatile LAS unsigned* st) {
    XcdBarrier b; b.bar = bar; b.x = xb_xcc_id(); b.st = st;
    if (threadIdx.x == 0) (void)xb_add(&bar[XB_XCNT(b.x)], 1u);
    return b;
}
DI void xcd_barrier_complete(unsigned* bar, unsigned x, unsigned& nloc, unsigned& nx) {
    const unsigned G = gridDim.x * gridDim.y * gridDim.z;
    unsigned sum, cnt, mine, sp = 0u;
    for (;;) {
        sum = 0u; cnt = 0u; mine = 0u;
#pragma unroll
        for (unsigned j = 0; j < 16; ++j) { const unsigned c = xb_ld(&bar[XB_XCNT(j)]); sum += c; cnt += (c > 0u) ? 1u : 0u; mine = (j == x) ? c : mine; }
        if (sum == G) break;
        __builtin_amdgcn_s_sleep(1);
        if ((++sp & 255u) == 0u) { if (xb_ld(&bar[XB_TMO])) break; if (sp > XB_SPIN_CAP) { atomicAdd(&bar[XB_TMO], 1u); break; } }
    }
    nloc = mine > 0u ? mine : 1u; nx = cnt > 0u ? cnt : 1u;
}
DI void xcd_barrier(const XcdBarrier& b) {
    asm volatile("s_waitcnt vmcnt(0)" ::: "memory");
    __syncthreads();
    if (threadIdx.x == 0) {
        unsigned* bar = b.bar;
        __builtin_amdgcn_s_waitcnt(0);
        unsigned nloc = b.st[0], nx = b.st[1];
        if (nloc == 0u) { xcd_barrier_complete(bar, b.x, nloc, nx); b.st[0] = nloc; b.st[1] = nx; }
        const unsigned old = xb_add(&bar[XB_XSUB(b.x)], 1u);
        const unsigned gen = old / nloc;
        if (old + 1u == (gen + 1u) * nloc) {
            __builtin_amdgcn_fence(__ATOMIC_RELEASE, "agent");
            asm volatile("s_waitcnt vmcnt(0)" ::: "memory");
            const unsigned og = xb_add(&bar[XB_TOP], 1u);
            const unsigned tg = og / nx;
            if (og + 1u == (tg + 1u) * nx) xb_add(&bar[XB_TOPGEN], 1u);
            else XB_SPIN(xb_ld(&bar[XB_TOPGEN]) == tg, bar);
            __builtin_amdgcn_fence(__ATOMIC_ACQUIRE, "agent");
            xb_add(&bar[XB_XGEN(b.x)], 1u);
            asm volatile("s_waitcnt vmcnt(0)" ::: "memory");
        } else {
            XB_SPIN(xb_ld(&bar[XB_XGEN(b.x)]) == gen, bar);
            __builtin_amdgcn_fence(__ATOMIC_ACQUIRE, "agent");
            asm volatile("s_waitcnt vmcnt(0)" ::: "memory");
        }
    }
    __syncthreads();
}

struct MKArgs { const float* in[17]; float* out; unsigned char* ws; int s_lo, s_hi, li, pad; };
static_assert(sizeof(MKArgs) == 17 * 8 + 8 + 8 + 16, "no padding bytes");

DI void p0_transpose_item(const float* W, int K, int N, bf16_t* WT, LAS float* scr, int kb, int nb, int lane) {
    const int k0 = 64 * kb, n0 = 32 * nb;
    const bool nok = n0 + (lane & 31) < N;
#pragma unroll 8
    for (int i = 0; i < 32; ++i) { const int kk = 2 * i + (lane >> 5); scr[kk * 33 + (lane & 31)] = nok ? W[(size_t)(k0 + kk) * N + n0 + (lane & 31)] : 0.f; }
    asm volatile("s_waitcnt lgkmcnt(0)" ::: "memory");
    const int c = lane & 7;
#pragma unroll
    for (int j = 0; j < 4; ++j) { const int n = (lane >> 3) + 8 * j; const LAS float* s = scr + (8 * c) * 33 + n;
        uint4 o; o.x = pk2(s[0 * 33], s[1 * 33]); o.y = pk2(s[2 * 33], s[3 * 33]); o.z = pk2(s[4 * 33], s[5 * 33]); o.w = pk2(s[6 * 33], s[7 * 33]);
        *(uint4*)(WT + (size_t)(n0 + n) * K + k0 + 8 * c) = o; }
    asm volatile("s_waitcnt lgkmcnt(0)" ::: "memory");
}

__global__ void __launch_bounds__(NTHREADS, 2) mk_fwd(MKArgs args) {
    extern __shared__ __attribute__((aligned(16))) unsigned char lds_raw[];
    LAS unsigned char* lds = (LAS unsigned char*)lds_raw;
    const int G = gridDim.x, blk = blockIdx.x, NGW = G * NWAVES;
#define PHASE_IDS PHASE_PTRS; const int tid = opaque_tid(), lane = tid & 63, wave = __builtin_amdgcn_readfirstlane(tid >> 6), gw = blk * NWAVES + wave; (void)lane; (void)gw
    typedef const __attribute__((address_space(4))) char* kp_t;
    const kp_t kp0 = (kp_t)__builtin_amdgcn_kernarg_segment_ptr();
#define KLD(T_, off) (*(T_ const __attribute__((address_space(4)))*)(kq + (off)))
#define PHASE_PTRS kp_t kq = kp0; asm volatile("" : "+s"(kq)); \
    unsigned char* ws = KLD(unsigned char*, 18 * 8); unsigned* CTL = (unsigned*)(ws + WS_CTL); \
    const float* x_in = KLD(const float*, 0 * 8); const float* c_in = KLD(const float*, 1 * 8); const float* w_ada = KLD(const float*, 2 * 8); const float* b_ada = KLD(const float*, 3 * 8); \
    const float* w_in = KLD(const float*, 4 * 8); const float* w_out = KLD(const float*, 5 * 8); const float* diff_lam = KLD(const float*, 6 * 8); const float* diff_g = KLD(const float*, 7 * 8); \
    const float* ln_g = KLD(const float*, 8 * 8); const float* ln_b = KLD(const float*, 9 * 8); const float* w_router = KLD(const float*, 10 * 8); const float* b_router = KLD(const float*, 11 * 8); \
    const float* w1 = KLD(const float*, 12 * 8); const float* b1 = KLD(const float*, 13 * 8); const float* w2 = KLD(const float*, 14 * 8); const float* b2 = KLD(const float*, 15 * 8); const float* rel_bias = KLD(const float*, 16 * 8); \
    float* out_p = KLD(float*, 17 * 8); \
    float* MOD = (float*)(ws + WS_MOD); float* MODP = (float*)(ws + WS_MODP); \
    int* TE = (int*)(ws + WS_TE); float* TG = (float*)(ws + WS_TG); int* LIST = (int*)(ws + WS_LIST); unsigned* MASK = (unsigned*)(ws + WS_MASK); \
    bf16_t* WIN_T = (bf16_t*)(ws + WS_WIN); bf16_t* WOUT_T = (bf16_t*)(ws + WS_WOUT); bf16_t* W1_T = (bf16_t*)(ws + WS_W1); bf16_t* W2_T = (bf16_t*)(ws + WS_W2); \
    bf16_t* HN = (bf16_t*)(ws + WS_HN); bf16_t* MG = (bf16_t*)(ws + WS_MERGED); bf16_t* Y1 = (bf16_t*)(ws + WS_Y1); float* X1 = (float*)(ws + WS_X1); float* XB = (float*)(ws + WS_XB); \
    bf16_t* P = (bf16_t*)(ws + WS_P); float* SC = (float*)(ws + WS_BIG); bf16_t* GB = (bf16_t*)(ws + WS_G); bf16_t* YP = (bf16_t*)(ws + WS_YP); \
    (void)CTL; (void)x_in; (void)c_in; (void)w_ada; (void)b_ada; (void)w_in; (void)w_out; (void)diff_lam; (void)diff_g; (void)ln_g; (void)ln_b; (void)w_router; (void)b_router; (void)w1; (void)b1; (void)w2; (void)b2; (void)rel_bias; (void)out_p; \
    (void)MOD; (void)MODP; (void)TE; (void)TG; (void)LIST; (void)MASK; (void)WIN_T; (void)WOUT_T; (void)W1_T; (void)W2_T; (void)HN; (void)MG; (void)Y1; (void)X1; (void)XB; (void)P; (void)SC; (void)GB; (void)YP
    volatile LAS unsigned* MISC = (volatile LAS unsigned*)(lds + MISC_OFF);
    if (threadIdx.x < 64) MISC[threadIdx.x] = 0u;
    __syncthreads();
    const int lo = args.s_lo, hi = args.s_hi;
    unsigned* barw = (unsigned*)(args.ws + WS_CTL) + CW_BAR + args.li * XCD_BAR_WORDS;
    XcdBarrier bar; bar.bar = barw; bar.x = 0; bar.st = MISC + 8;
    if (hi - lo > 1) bar = xcd_barrier_post(barw, MISC + 8);
#ifndef PHASE_EN
#define PHASE_EN 0xFFFFFFFFull
#endif
#define PEN(k) ((PHASE_EN >> ((k) < 3 ? (k) : 3 + ((k) - 3) % 12)) & 1ull)
#define IN(k) (PEN(k) && lo <= (k) && (k) < hi)
#define SEAM(k) do { if (IN(k) && IN((k) + 1)) xcd_barrier(bar); } while (0)

    if (IN(0)) { PHASE_IDS;
        for (int idx = blk * NTHREADS + tid; idx < 8 * 2 * 6144; idx += G * NTHREADS) {
            const int kc = idx / 12288, l = (idx / 6144) & 1, j = idx % 6144;
            const float* w = w_ada + (size_t)l * D * 6144 + (size_t)(kc * 128) * 6144 + j;
            float acc[8];
#pragma unroll
            for (int b = 0; b < 8; ++b) acc[b] = 0.f;
            for (int k = 0; k < 128; ++k) { const float wv = w[(size_t)k * 6144];
#pragma unroll
                for (int b = 0; b < 8; ++b) acc[b] += c_in[b * D + kc * 128 + k] * wv; }
#pragma unroll
            for (int b = 0; b < 8; ++b) MODP[((size_t)(kc * 2 + l) * 8 + b) * 6144 + j] = acc[b];
        }
        LAS float* scr = (LAS float*)(lds + wave * 16384);
        constexpr int I_IN = 16 * 131, I_OUT = 16 * 32, I_1 = 16 * 64, I_2 = 16 * 32;
        constexpr int NITEMS = 2 * I_IN + 2 * I_OUT + 64 * I_1 + 64 * I_2;
        for (int it = gw; it < NITEMS; it += NGW) {
            int r = it;
            if (r < 2 * I_IN) { const int l = r / I_IN, q = r % I_IN; p0_transpose_item(w_in + (size_t)l * D * INC, D, INC, WIN_T + (size_t)l * PP * D, scr, q / 131, q % 131, lane); continue; } r -= 2 * I_IN;
            if (r < 2 * I_OUT) { const int l = r / I_OUT, q = r % I_OUT; p0_transpose_item(w_out + (size_t)l * D * D, D, D, WOUT_T + (size_t)l * D * D, scr, q / 32, q % 32, lane); continue; } r -= 2 * I_OUT;
            if (r < 64 * I_1) { const int m = r / I_1, q = r % I_1; p0_transpose_item(w1 + (size_t)m * D * 2048, D, 2048, W1_T + (size_t)m * 2048 * D, scr, q / 64, q % 64, lane); continue; } r -= 64 * I_1;
            { const int m = r / I_2, q = r % I_2; p0_transpose_item(w2 + (size_t)m * FF * D, FF, D, W2_T + (size_t)m * D * FF, scr, q / 32, q % 32, lane); }
        }
    }
    SEAM(0);
    if (IN(1)) { PHASE_IDS;
        for (int idx = blk * NTHREADS + tid; idx < 2 * 8 * 6144; idx += G * NTHREADS) {
            const int l = idx / (8 * 6144), b = (idx / 6144) & 7, j = idx % 6144;
            float a = b_ada[l * 6144 + j];
#pragma unroll
            for (int kc = 0; kc < 8; ++kc) a += MODP[((size_t)(kc * 2 + l) * 8 + b) * 6144 + j];
            MOD[idx] = a;
        }
    }
    SEAM(1);
    if (IN(2)) { PHASE_IDS;
        for (int row = gw; row < M; row += NGW) {
            const float* mod = MOD + (size_t)(0 * NB + row / T) * 6144;
            Row r = row_load(x_in + (size_t)row * D, lane);
            row_ln(r); row_affine(r, mod + 1024, mod, lane, true);
            row_store_bf16(r, HN + (size_t)row * D, lane);
        }
    }
    SEAM(2);
#pragma unroll 1
    for (int l = 0; l < DEPTH; ++l) {
        const int sb = 3 + 12 * l;
        if (IN(sb + 0)) { PHASE_PTRS;
            pg8::StaticOrder S; S.init(HN, WIN_T + (size_t)l * PP * D, M, PP, D, G, blk);
            pg8::EpiBf16 E{P, PP};
            pg8::gemm_phase(lds, D, S, E);
        }
        SEAM(sb + 0);
        if (IN(sb + 1)) { PHASE_IDS;
            for (int u = gw; u < NB * 4 * (T / 32); u += NGW) { const int qblk = u % (T / 32), h = (u / (T / 32)) & 3, b = u / (4 * (T / 32));
                att::attnA_unit((LAS char*)(lds + wave * 16384), P, MG, b, h, qblk, lane); }
        }
        SEAM(sb + 1);
        if (IN(sb + 2)) { PHASE_IDS;
            for (int u = gw; u < NB * 4 * 128; u += NGW) { const int ub = u & 7, rho = (u >> 3) & 15, h = (u >> 7) & 3, b = u >> 9;
                att::attnB_unit((LAS char*)(lds + wave * 16384), (LAS float*)(lds + TAB_OFF + wave * 1584), P, rel_bias, MG, b, h, rho, ub, lane); }
        }
        SEAM(sb + 2);
        if (IN(sb + 3)) { PHASE_IDS;
            for (int u = blk; u < NB * (T / 64); u += G) { const int b = u & 7, ix = u >> 3, q64 = ix < 32 ? 63 - ix : ix - 32;
                att::idx_unit((LAS char*)lds, P, SC, b, q64, tid); }
        }
        SEAM(sb + 3);
        if (IN(sb + 4)) { PHASE_IDS;
            for (int row = gw; row < M; row += NGW) select_row(SC + (size_t)row * T, (unsigned long long*)(MASK + (size_t)row * 128), row % T, lane);
        }
        SEAM(sb + 4);
        if (IN(sb + 5) || IN(sb + 6)) { PHASE_IDS;
            LAS float* btab = (LAS float*)(lds + BTAB_OFF);
            float s1 = 0.f, s2 = 0.f;
            if (lane < 32) { const float* lp = diff_lam + l * 128; s1 = lp[lane] * lp[32 + lane]; s2 = lp[64 + lane] * lp[96 + lane]; }
            s1 = wave_sum(s1); s2 = wave_sum(s2);
            const float lam_init = 0.8f - 0.6f * __expf(-0.3f * (float)l), lam = __expf(s1) - __expf(s2) + lam_init;
#pragma unroll 1
            for (int md = 0; md < 2; ++md) {
                if (!IN(sb + 5 + md)) continue;
                int hprev = -1;
                for (int u = blk; u < NB * 4 * (T / 256); u += G) { const int bh = u & 31, b = bh >> 2, h = bh & 3, ix = u >> 5, qb = ix < 8 ? 15 - ix : ix - 8;
                    const int hcol = (md == 0 ? 4 : 8) + h;
                    if (h != hprev) { __syncthreads(); if (tid < 320) btab[tid] = tid < 96 ? -INFINITY : rel_bias[rel_bucket(tid - 96) * 12 + hcol] * LOG2E; __syncthreads(); hprev = h; }
                    const float far2 = rel_bias[31 * 12 + hcol] * LOG2E;
                    if (md == 0) att::dense_unit<0>((LAS char*)lds, btab, far2, P, MASK, diff_g + l * 64, lam, lam_init, MG, b, h, qb, tid);
                    else att::dense_unit<1>((LAS char*)lds, btab, far2, P, MASK, diff_g + l * 64, lam, lam_init, MG, b, h, qb, tid);
                }
                if (md == 0) SEAM(sb + 5);
            }
        }
        SEAM(sb + 6);
        if (IN(sb + 7)) { PHASE_PTRS;
            pg8::StaticOrder S; S.init(MG, WOUT_T + (size_t)l * D * D, M, D, D, G, blk);
            pg8::EpiBf16 E{Y1, D};
            pg8::gemm_phase(lds, D, S, E);
        }
        SEAM(sb + 7);
        if (IN(sb + 8)) { PHASE_IDS; const float* xin = l == 0 ? x_in : XB; int* CNT = (int*)CTL + C_CNT + l * NE;
            LAS float* hs = (LAS float*)(lds + wave * 4096);
            LAS int* hist = (LAS int*)(lds + 32768); LAS int* hbase = hist + 32; LAS int* pendE = hist + 64 + wave * 128; LAS int* pendP = pendE + 64;
            for (int it = 0; it * G * NWAVES < M / 16; ++it) {
                const int cidx = (it * G + blk) * NWAVES + wave; const bool active = cidx < M / 16;
                if (tid < 32) hist[tid] = 0;
                __syncthreads();
                if (active) {
#pragma unroll 1
                    for (int rr = 0; rr < 16; ++rr) {
                        const int row = cidx * 16 + rr; const float* mod = MOD + (size_t)(l * NB + row / T) * 6144;
                        Row r = row_load(xin + (size_t)row * D, lane);
                        const Row y = row_load_bf16(Y1 + (size_t)row * D, lane);
                        row_resid(r, y, mod + 2048, lane);
                        row_ln(r); row_affine(r, ln_g + (l * 2 + 0) * D, ln_b + (l * 2 + 0) * D, lane, false);
                        row_store_f32(r, X1 + (size_t)row * D, lane);
                        row_ln(r); row_affine(r, mod + 4096, mod + 3072, lane, true);
                        row_store_bf16(r, HN + (size_t)row * D, lane);
                        _Pragma("unroll") for (int j = 0; j < 4; ++j) { typedef float f4v __attribute__((ext_vector_type(4))); *(LAS f4v*)(hs + 4 * lane + 256 * j) = (f4v){r.v[j].x, r.v[j].y, r.v[j].z, r.v[j].w}; }
                        asm volatile("s_waitcnt lgkmcnt(0)" ::: "memory");
                        int e4; float g4;
                        router_top4((const LAS float*)hs, w_router + (size_t)l * D * NE, b_router + l * NE, lane, e4, g4);
                        if (lane < 4) { const int lp = __hip_atomic_fetch_add(&hist[e4], 1, __ATOMIC_RELAXED, __HIP_MEMORY_SCOPE_WORKGROUP); pendE[rr * 4 + lane] = e4; pendP[rr * 4 + lane] = lp; TE[row * 4 + lane] = e4; TG[row * 4 + lane] = g4; }
                    }
                }
                __syncthreads();
                if (tid < 32) hbase[tid] = atomicAdd(&CNT[tid], hist[tid]);
                __syncthreads();
                if (active) { const int e = pendE[lane], lp = pendP[lane]; LIST[(size_t)e * LCAP + hbase[e] + lp] = (cidx * 16 + (lane >> 2)) * 4 + (lane & 3); }
                __syncthreads();
            }
        }
        SEAM(sb + 8);
        if (IN(sb + 9)) { PHASE_PTRS; int* CNT = (int*)CTL + C_CNT + l * NE;
            pg8::GroupedOrder S; S.init(HN, W1_T + (size_t)l * NE * 2048 * D, CNT, LIST, 2048, D, 2, G, blk);
            pg8::EpiSwiglu E{GB, b1 + (size_t)l * NE * 2048};
            pg8::gemm_phase(lds, D, S, E);
        }
        SEAM(sb + 9);
        if (IN(sb + 10)) { PHASE_PTRS; int* CNT = (int*)CTL + C_CNT + l * NE;
            pg8::GroupedOrder S; S.init(GB, W2_T + (size_t)l * NE * D * FF, CNT, LIST, D, FF, 0, G, blk);
            pg8::EpiBiasScatter E{YP, b2 + (size_t)l * NE * D};
            pg8::gemm_phase(lds, FF, S, E);
        }
        SEAM(sb + 10);
        if (IN(sb + 11)) { PHASE_IDS; float* xout = l == DEPTH - 1 ? out_p : XB;
            for (int row = gw; row < M; row += NGW) {
                const float* mod = MOD + (size_t)(l * NB + row / T) * 6144;
                Row r = row_load(X1 + (size_t)row * D, lane);
                Row y;
                _Pragma("unroll") for (int j = 0; j < 4; ++j) y.v[j] = make_float4(0.f, 0.f, 0.f, 0.f);
#pragma unroll
                for (int k = 0; k < 4; ++k) { const float g = TG[row * 4 + k]; const Row yk = row_load_bf16(YP + (size_t)(row * 4 + k) * D, lane);
                    _Pragma("unroll") for (int j = 0; j < 4; ++j) { y.v[j].x += g * yk.v[j].x; y.v[j].y += g * yk.v[j].y; y.v[j].z += g * yk.v[j].z; y.v[j].w += g * yk.v[j].w; } }
                row_resid(r, y, mod + 5120, lane);
                row_ln(r); row_affine(r, ln_g + (l * 2 + 1) * D, ln_b + (l * 2 + 1) * D, lane, false);
                row_store_f32(r, xout + (size_t)row * D, lane);
                if (l + 1 < DEPTH) { const float* modn = MOD + (size_t)((l + 1) * NB + row / T) * 6144;
                    row_ln(r); row_affine(r, modn + 1024, modn, lane, true); row_store_bf16(r, HN + (size_t)row * D, lane); }
            }
        }
        SEAM(sb + 11);
    }
#undef IN
#undef SEAM
}
constexpr int NSTEPS = 3 + 12 * DEPTH;

#ifndef FASTMASK
#define FASTMASK 0x7ffffffull
#endif
#ifndef FUSE
#define FUSE 1
#endif
extern "C" void kernel_launch(void* const* d_in, const int* in_sizes, int n_in, void* d_out, int out_size, void* d_ws, size_t ws_size, hipStream_t stream) {
    static int grid = 0;
    if (grid == 0) {
        if (n_in != 17 || out_size != M * D || ws_size < WS_END) { fprintf(stderr, "kernel_launch: unexpected arguments (n_in %d, out %d, ws %zu)\n", n_in, out_size, ws_size); grid = -1; return; }
        int dev = 0, cus = 0, per_cu = 0;
        if (hipGetDevice(&dev) != hipSuccess || hipDeviceGetAttribute(&cus, hipDeviceAttributeMultiprocessorCount, dev) != hipSuccess) { grid = -1; return; }
        if (hipFuncSetAttribute((const void*)mk_fwd, hipFuncAttributeMaxDynamicSharedMemorySize, LDS_BYTES) != hipSuccess) { fprintf(stderr, "kernel_launch: hipFuncSetAttribute failed\n"); grid = -1; return; }
        if (hipOccupancyMaxActiveBlocksPerMultiprocessor(&per_cu, (const void*)mk_fwd, NTHREADS, LDS_BYTES) != hipSuccess || per_cu < 1) { fprintf(stderr, "kernel_launch: occupancy query says %d\n", per_cu); }
        (void)hipGetLastError();
        grid = cus;
    }
    if (grid < 0) return;
    const float* in[17]; for (int i = 0; i < 17; ++i) in[i] = (const float*)d_in[i];
    unsigned char* ws = (unsigned char*)d_ws;
    int* CTL = (int*)(ws + WS_CTL); float* MOD = (float*)(ws + WS_MOD);
    int* TE = (int*)(ws + WS_TE); float* TG = (float*)(ws + WS_TG); int* LIST = (int*)(ws + WS_LIST); unsigned* MASK = (unsigned*)(ws + WS_MASK);
    bf16_t* HN = (bf16_t*)(ws + WS_HN); bf16_t* MG = (bf16_t*)(ws + WS_MERGED); bf16_t* Y1 = (bf16_t*)(ws + WS_Y1); float* X1 = (float*)(ws + WS_X1); float* XB = (float*)(ws + WS_XB);
    bf16_t* P = (bf16_t*)(ws + WS_P); float* SC = (float*)(ws + WS_BIG); bf16_t* GB = (bf16_t*)(ws + WS_G); bf16_t* YP = (bf16_t*)(ws + WS_YP);
    (void)hipMemsetAsync(ws + WS_CTL, 0, 1 * MiB, stream);
    const unsigned long long fast = FASTMASK;
    int s = 0, li = 0;
    while (s < NSTEPS) {
        if ((fast >> s) & 1ull) {
            int e = s + 1;
            if (FUSE) while (e < NSTEPS && ((fast >> e) & 1ull)) ++e;
            MKArgs a{}; for (int i = 0; i < 17; ++i) a.in[i] = in[i]; a.out = (float*)d_out; a.ws = ws; a.s_lo = s; a.s_hi = e; a.li = li++;
            hipLaunchKernelGGL(mk_fwd, dim3(grid), dim3(NTHREADS), LDS_BYTES, stream, a);
            s = e; continue;
        }
        if (s == 0) k_mod<<<dim3(24, NB, DEPTH), 256, 0, stream>>>(in[1], in[2], in[3], MOD);
        else if (s == 1) { }
        else if (s == 2) k_lnmod<<<M / 4, 256, 0, stream>>>(in[0], MOD, 0, HN);
        else {
            const int l = (s - 3) / 12, p = (s - 3) % 12;
            const float* xin = l == 0 ? in[0] : XB; float* xout = l == DEPTH - 1 ? (float*)d_out : XB;
            int* CNT = CTL + C_CNT + l * NE;
            switch (p) {
            case 0: { GArgs a{HN, in[4] + (size_t)l * D * INC, nullptr, P, nullptr, nullptr, INC, D, 0, 0}; k_gemm<0><<<dim3(M / 64, (INC + 63) / 64), 256, 0, stream>>>(a); } break;
            case 1: k_attnA<<<dim3(T / 64, 4, NB), 64, 0, stream>>>(P, MG); break;
            case 2: k_attnB<<<dim3(T / 64, 4, NB), 64, 0, stream>>>(P, in[16], MG); break;
            case 3: k_idx_scores<<<dim3(T, NB), 256, 0, stream>>>(P, SC); break;
            case 4: k_select<<<M / 4, 256, 0, stream>>>(SC, MASK); break;
            case 5: k_attnC<<<dim3(T / 64, 4, NB), 64, 0, stream>>>(P, MASK, in[16], MG); break;
            case 6: k_attnD<<<dim3(T / 64, 4, NB), 64, 0, stream>>>(P, in[16], in[6], in[7], l, MG); break;
            case 7: { GArgs a{MG, in[5] + (size_t)l * D * D, nullptr, Y1, nullptr, nullptr, D, D, 0, 0}; k_gemm<1><<<dim3(M / 64, D / 64), 256, 0, stream>>>(a); } break;
            case 8: k_post1<<<M / 4, 256, 0, stream>>>(xin, Y1, MOD, in[8], in[9], in[10], in[11], l, X1, HN, TE, TG, CTL + C_CNT, LIST); break;
            case 9: { GArgs a{HN, in[12] + (size_t)l * NE * D * 2 * FF, in[13] + (size_t)l * NE * 2 * FF, GB, LIST, CNT, 2 * FF, D, 0, 0}; k_gemm<2><<<dim3(M / 64, 2 * FF / 64, NE), 256, 0, stream>>>(a); } break;
            case 10: { GArgs a{GB, in[14] + (size_t)l * NE * FF * D, in[15] + (size_t)l * NE * D, YP, LIST, CNT, D, FF, 0, 0}; k_gemm<3><<<dim3(M / 64, D / 64, NE), 256, 0, stream>>>(a); } break;
            case 11: k_final<<<M / 4, 256, 0, stream>>>(X1, YP, MOD, in[8], in[9], TG, l, xout);
                     if (l + 1 < DEPTH) k_lnmod<<<M / 4, 256, 0, stream>>>(XB, MOD, l + 1, HN);
                     break;
            }
        }
        ++s;
    }
}
```
